# Optimizing an MI355X kernel written in HIP

```python
import math
import jax, jax.numpy as jnp
from jax import lax
import numpy as np

D_MODEL = 2048
BATCH = 8
SEQ = 2048
DEPTH = 1

N_QK_HEADS = 16
N_V_HEADS = 32
HEAD_K = 128
HEAD_V = 128
CONV_WIDTH = 4
CHUNK = 64
QK_WIDTH = N_QK_HEADS * HEAD_K
V_WIDTH = N_V_HEADS * HEAD_V
CONV_CH = 2 * QK_WIDTH + V_WIDTH

POOL_WINDOWS = (2, 4, 8, 16)
N_POOL_GROUPS = len(POOL_WINDOWS)
POOL_WIDTH = D_MODEL
POOL_GROUP = POOL_WIDTH // N_POOL_GROUPS

N_EXPERTS = 32
TOP_K = 4
D_EXPERT = D_MODEL
SWIGLU_ALPHA = 1.702
SWIGLU_LIMIT = 7.0
EXPERT_BLOCK = 128

RMS_EPS = 1e-6
L2_EPS = 1e-6

IN_SIZES = (CONV_CH, V_WIDTH, N_V_HEADS, N_V_HEADS, POOL_WIDTH, D_MODEL, D_MODEL)
IN_WIDTH = sum(IN_SIZES)
SPLIT_POINTS = tuple(int(s) for s in np.cumsum(IN_SIZES)[:-1])

kernel_name = 'gated_delta_pool_moe_hybrid'


def rmsnorm(x, w):
    xf = x.astype(jnp.float32)
    r = xf * lax.rsqrt(jnp.mean(xf * xf, axis=-1, keepdims=True) + RMS_EPS)
    return (r * w.astype(jnp.float32)).astype(x.dtype)


def l2norm(x):
    return x * lax.rsqrt(jnp.sum(x * x, axis=-1, keepdims=True) + L2_EPS)


def causal_depthwise_conv(u, w):
    S = u.shape[1]
    up = jnp.pad(u, ((0, 0), (CONV_WIDTH - 1, 0), (0, 0)))
    return sum(up[:, i:i + S] * w[i] for i in range(CONV_WIDTH))


def chunk_gated_delta_rule(q, k, v, g, beta):
    B, S, H, DK = q.shape
    DV = v.shape[-1]
    N = S // CHUNK
    f32 = jnp.float32
    q, k, v, g, beta = (t.astype(f32) for t in (q, k, v, g, beta))
    q = l2norm(q) * (DK ** -0.5)
    k = l2norm(k)

    def chunks(t):
        t = t.reshape((B, N, CHUNK, H) + t.shape[3:])
        return jnp.moveaxis(t, 3, 1)

    q, k, v, g, beta = (chunks(t) for t in (q, k, v, g, beta))
    g_cum = jnp.cumsum(g, axis=-1)
    idx = jnp.arange(CHUNK)
    incl = idx[:, None] >= idx[None, :]
    strict = idx[:, None] > idx[None, :]
    decay = jnp.exp(jnp.where(incl, g_cum[..., :, None] - g_cum[..., None, :], -jnp.inf))
    kk = jnp.einsum('bhnid,bhnjd->bhnij', k, k)
    lower = jnp.where(strict, kk * decay * beta[..., :, None], 0.0)
    a_mat = lower + jnp.eye(CHUNK, dtype=f32)
    rhs = jnp.concatenate([v * beta[..., None], k * (beta * jnp.exp(g_cum))[..., None]], axis=-1)
    sol = lax.linalg.triangular_solve(a_mat, rhs, left_side=True, lower=True, unit_diagonal=True)
    u, w = sol[..., :DV], sol[..., DV:]
    qk = jnp.einsum('bhnid,bhnjd->bhnij', q, k) * decay
    q_dec = q * jnp.exp(g_cum)[..., None]
    k_dec = k * jnp.exp(g_cum[..., -1:] - g_cum)[..., None]
    chunk_decay = jnp.exp(g_cum[..., -1])
    xs = tuple(jnp.moveaxis(t, 2, 0) for t in (qk, q_dec, k_dec, u, w, chunk_decay))

    def step(state, inp):
        qk_c, q_c, k_c, u_c, w_c, d_c = inp
        v_new = u_c - jnp.einsum('bhck,bhkv->bhcv', w_c, state)
        o_c = jnp.einsum('bhck,bhkv->bhcv', q_c, state) + jnp.einsum('bhij,bhjv->bhiv', qk_c, v_new)
        state = state * d_c[..., None, None] + jnp.einsum('bhck,bhcv->bhkv', k_c, v_new)
        return state, o_c

    state0 = jnp.zeros((B, H, DK, DV), f32)
    _, o = lax.scan(step, state0, xs)
    return jnp.transpose(o, (1, 0, 3, 2, 4)).reshape(B, S, H, DV)


def multiscale_pool(p, w_pool, pool_scale):
    B, S, _ = p.shape
    pg = p.reshape(B, S, N_POOL_GROUPS, POOL_GROUP).astype(jnp.float32)
    c = jnp.pad(jnp.cumsum(pg, axis=1), ((0, 0), (1, 0), (0, 0), (0, 0)))
    pos = jnp.arange(1, S + 1, dtype=jnp.float32)
    groups = []
    for gi, win in enumerate(POOL_WINDOWS):
        cg = c[:, :, gi]
        lower = jnp.pad(cg, ((0, 0), (win - 1, 0), (0, 0)))[:, :S]
        count = jnp.minimum(pos, float(win))[None, :, None]
        groups.append((cg[:, 1:] - lower) / count - pg[:, :, gi])
    mixed = jnp.stack(groups, axis=2)
    y = jnp.einsum('bsgc,gce->bsge', mixed, w_pool.astype(jnp.float32))
    y = y * pool_scale.astype(jnp.float32).reshape(N_POOL_GROUPS, POOL_GROUP)
    return y.reshape(B, S, POOL_WIDTH).astype(p.dtype)


def hybrid_mixer(xn, w_in, b_gate, conv_w, A_log, dt_bias, onorm_w,
                 w_branch_a, w_pool, pool_scale, w_branch_p, w_out):
    B, S, _ = xn.shape
    proj = jnp.einsum('bsd,de->bse', xn, w_in)
    qkv, z, a, b, p, ga, gp = jnp.split(proj, SPLIT_POINTS, axis=-1)
    qkv = jax.nn.silu(causal_depthwise_conv(qkv, conv_w))
    q, k, v = jnp.split(qkv, [QK_WIDTH, 2 * QK_WIDTH], axis=-1)
    rep = N_V_HEADS // N_QK_HEADS
    q = jnp.repeat(q.reshape(B, S, N_QK_HEADS, HEAD_K), rep, axis=2)
    k = jnp.repeat(k.reshape(B, S, N_QK_HEADS, HEAD_K), rep, axis=2)
    v = v.reshape(B, S, N_V_HEADS, HEAD_V)
    beta = jax.nn.sigmoid(b.astype(jnp.float32))
    g = -jnp.exp(A_log.astype(jnp.float32)) * jax.nn.softplus(a.astype(jnp.float32) + dt_bias.astype(jnp.float32))
    o = chunk_gated_delta_rule(q, k, v, g, beta)
    o = rmsnorm(o, onorm_w) * jax.nn.silu(z.reshape(B, S, N_V_HEADS, HEAD_V).astype(jnp.float32))
    o_a = o.reshape(B, S, V_WIDTH).astype(xn.dtype)
    o_p = multiscale_pool(p, w_pool, pool_scale)
    gate_a = jax.nn.sigmoid(ga + b_gate[:D_MODEL])
    gate_p = jax.nn.sigmoid(gp + b_gate[D_MODEL:])
    h = gate_a * jnp.einsum('bsv,vd->bsd', o_a, w_branch_a) + gate_p * jnp.einsum('bsp,pd->bsd', o_p, w_branch_p)
    return jnp.einsum('bsd,de->bse', h, w_out)


def clamped_swiglu(h):
    x_glu = jnp.minimum(h[..., ::2], SWIGLU_LIMIT)
    x_lin = jnp.clip(h[..., 1::2], -SWIGLU_LIMIT, SWIGLU_LIMIT)
    return x_glu * jax.nn.sigmoid(SWIGLU_ALPHA * x_glu) * (x_lin + 1.0)


def moe_ffn(xn, router_w, router_b, w1, b1, w2, b2):
    B, S, D = xn.shape
    T = B * S
    xf = xn.reshape(T, D)
    logits = jnp.einsum('td,de->te', xf, router_w).astype(jnp.float32) + router_b.astype(jnp.float32)
    top_vals, top_idx = lax.top_k(logits, TOP_K)
    gates = jax.nn.softmax(top_vals, axis=-1)
    A = T * TOP_K
    flat_e = top_idx.reshape(A).astype(jnp.int32)
    flat_tok = jnp.arange(A, dtype=jnp.int32) // TOP_K
    flat_g = gates.reshape(A)
    order = jnp.argsort(flat_e)
    se, stok, sg = flat_e[order], flat_tok[order], flat_g[order]
    counts = jnp.zeros((N_EXPERTS,), jnp.int32).at[flat_e].add(1)
    padded = (counts + EXPERT_BLOCK - 1) // EXPERT_BLOCK * EXPERT_BLOCK
    start = jnp.cumsum(counts) - counts
    pend = jnp.cumsum(padded)
    pstart = pend - padded
    dest = pstart[se] + (jnp.arange(A, dtype=jnp.int32) - start[se])
    R = (A + EXPERT_BLOCK - 1) // EXPERT_BLOCK * EXPERT_BLOCK + N_EXPERTS * EXPERT_BLOCK
    n_blocks = R // EXPERT_BLOCK
    x_buf = jnp.zeros((R, D), xf.dtype).at[dest].set(xf[stok])
    block_start = jnp.arange(n_blocks, dtype=jnp.int32) * EXPERT_BLOCK
    block_expert = jnp.minimum(jnp.searchsorted(pend, block_start, side='right'), N_EXPERTS - 1)

    def expert_block(args):
        xb, e = args
        h = jnp.einsum('cd,df->cf', xb, w1[e]) + b1[e]
        return jnp.einsum('cf,fd->cd', clamped_swiglu(h), w2[e]) + b2[e]

    y_buf = lax.map(expert_block, (x_buf.reshape(n_blocks, EXPERT_BLOCK, D), block_expert)).reshape(R, D)
    y = y_buf[dest] * sg[:, None].astype(y_buf.dtype)
    out = jax.ops.segment_sum(y, stok, num_segments=T)
    return out.reshape(B, S, D).astype(xn.dtype)


def setup_inputs(seed: int = 0) -> dict:
    key = jax.random.key(seed)
    ks = jax.random.split(key, 24)
    f32 = jnp.float32
    L = DEPTH

    def nrm(k, shape, scale):
        return jax.random.normal(k, shape, f32) * scale

    x = nrm(ks[0], (BATCH, SEQ, D_MODEL), 1.0)
    norm1_w = 1.0 + nrm(ks[1], (L, D_MODEL), 0.02)
    w_in = nrm(ks[2], (L, D_MODEL, IN_WIDTH), D_MODEL ** -0.5)
    b_gate = nrm(ks[3], (L, 2 * D_MODEL), 0.02)
    conv_w = nrm(ks[4], (L, CONV_WIDTH, CONV_CH), CONV_WIDTH ** -0.5)
    A_log = jnp.log(jax.random.uniform(ks[5], (L, N_V_HEADS), f32, 1.0, 16.0))
    dt = jnp.exp(jax.random.uniform(ks[6], (L, N_V_HEADS), f32, math.log(1e-3), math.log(1e-1)))
    dt_bias = dt + jnp.log(-jnp.expm1(-dt))
    onorm_w = 1.0 + nrm(ks[7], (L, HEAD_V), 0.02)
    w_branch_a = nrm(ks[8], (L, V_WIDTH, D_MODEL), V_WIDTH ** -0.5)
    w_pool = nrm(ks[9], (L, N_POOL_GROUPS, POOL_GROUP, POOL_GROUP), POOL_GROUP ** -0.5)
    pool_scale = 1.0 + nrm(ks[10], (L, POOL_WIDTH), 0.1)
    w_branch_p = nrm(ks[11], (L, POOL_WIDTH, D_MODEL), POOL_WIDTH ** -0.5)
    w_out = nrm(ks[12], (L, D_MODEL, D_MODEL), D_MODEL ** -0.5)
    norm2_w = 1.0 + nrm(ks[13], (L, D_MODEL), 0.02)
    router_w = nrm(ks[14], (L, D_MODEL, N_EXPERTS), D_MODEL ** -0.5)
    router_b = nrm(ks[15], (L, N_EXPERTS), 0.01)
    w1 = nrm(ks[16], (L, N_EXPERTS, D_MODEL, 2 * D_EXPERT), D_MODEL ** -0.5)
    b1 = nrm(ks[17], (L, N_EXPERTS, 2 * D_EXPERT), 0.02)
    w2 = nrm(ks[18], (L, N_EXPERTS, D_EXPERT, D_MODEL), D_EXPERT ** -0.5)
    b2 = nrm(ks[19], (L, N_EXPERTS, D_MODEL), 0.02)
    norm_f_w = 1.0 + nrm(ks[20], (D_MODEL,), 0.02)
    return {'x': x, 'norm1_w': norm1_w, 'w_in': w_in, 'b_gate': b_gate, 'conv_w': conv_w,
            'A_log': A_log, 'dt_bias': dt_bias, 'onorm_w': onorm_w, 'w_branch_a': w_branch_a,
            'w_pool': w_pool, 'pool_scale': pool_scale, 'w_branch_p': w_branch_p, 'w_out': w_out,
            'norm2_w': norm2_w, 'router_w': router_w, 'router_b': router_b,
            'w1': w1, 'b1': b1, 'w2': w2, 'b2': b2, 'norm_f_w': norm_f_w}


def reference(x, norm1_w, w_in, b_gate, conv_w, A_log, dt_bias, onorm_w, w_branch_a,
              w_pool, pool_scale, w_branch_p, w_out, norm2_w, router_w, router_b,
              w1, b1, w2, b2, norm_f_w):
    for l in range(DEPTH):
        x = x + hybrid_mixer(rmsnorm(x, norm1_w[l]), w_in[l], b_gate[l], conv_w[l], A_log[l],
                             dt_bias[l], onorm_w[l], w_branch_a[l], w_pool[l], pool_scale[l],
                             w_branch_p[l], w_out[l])
        x = x + moe_ffn(rmsnorm(x, norm2_w[l]), router_w[l], router_b[l], w1[l], b1[l], w2[l], b2[l])
    return rmsnorm(x, norm_f_w)
```

```cpp
#include <hip/hip_runtime.h>
#include <cstdio>
#include <cstdint>

#ifndef MK_N_LAUNCHES
#define MK_N_LAUNCHES 1
#endif

#define GAS __attribute__((address_space(1)))
#define LAS __attribute__((address_space(3)))
typedef unsigned short bf16;
typedef unsigned v4u __attribute__((ext_vector_type(4)));
typedef unsigned v2u __attribute__((ext_vector_type(2)));
typedef float f32x4 __attribute__((ext_vector_type(4)));
typedef float f32x2 __attribute__((ext_vector_type(2)));
typedef float f32x16 __attribute__((ext_vector_type(16)));
typedef short bf16x8 __attribute__((ext_vector_type(8)));

constexpr int T = 16384, D = 2048, SEQ = 2048;
constexpr int NPROJ = 18432;
constexpr int PC_Z = 8192, PC_P = 12288, PC_GA = 14336, PC_GP = 16384;
constexpr int NWIN_T = 18688;
constexpr int NH = 32, HD = 128;
constexpr int NE = 32, TOPK = 4, DE = 2048;
constexpr int KCAT = 6144;
constexpr int LDX = 2048 + 64;
constexpr int RMAX = 65536 + 32 * 256;
constexpr float RMS_EPS = 1e-6f, L2_EPS = 1e-6f;

constexpr size_t MiB = 1u << 20;
constexpr size_t al(size_t x) { return (x + MiB - 1) / MiB * MiB; }
constexpr size_t WS_CTL = 0, CTL_BYTES = 1 * MiB;
constexpr size_t WS_ROUTE = WS_CTL + CTL_BYTES;
constexpr size_t RT_E = 0, RT_SLOT = 262144, RT_GATE = 524288, RT_ROWS = 786432, RT_RSTD = 1048576, RT_TILEE = 1114112, RT_RWT = 1179648  , RT_ROWTOK = 1441792  , ROUTE_BYTES = 2 * MiB;
constexpr size_t WS_WIN = WS_ROUTE + ROUTE_BYTES;
constexpr size_t WS_WCAT = WS_WIN + al((size_t)NWIN_T * LDX * 2);
constexpr size_t WS_WPOOL = WS_WCAT + al((size_t)D * KCAT * 2);
constexpr size_t WS_WOUT = WS_WPOOL + al((size_t)D * 512 * 2);
constexpr size_t WS_W1 = WS_WOUT + al((size_t)D * D * 2);
constexpr size_t WS_W2 = WS_W1 + al((size_t)NE * 2 * DE * D * 2);
constexpr size_t WS_XN = WS_W2 + al((size_t)NE * D * DE * 2);
constexpr size_t WS_PROJ = WS_XN + al((size_t)T * LDX * 2);
constexpr size_t WS_XBUF = WS_PROJ, WS_ACT = WS_PROJ + (size_t)RMAX * D * 2;
constexpr size_t WS_TOKMAP = WS_XBUF + 64 * MiB;
static_assert((size_t)T * D <= 64 * MiB && WS_TOKMAP + (size_t)NE * T * 4 <= WS_ACT, "XQ | TOKMAP inside the XBUF region");
constexpr size_t WS_AB = WS_PROJ + al((size_t)T * NPROJ * 2);
constexpr size_t WS_CONV = WS_AB + al((size_t)T * 256 * 4);
constexpr size_t WS_Y = WS_CONV;
constexpr size_t CONV_K = (size_t)8 * 16 * 2048 * 128, CONV_V = 2 * CONV_K;
constexpr size_t WS_MIXED = WS_CONV + al((size_t)T * 8192 * 2);
constexpr size_t WS_OCAT = WS_MIXED + al((size_t)T * D * 2);
constexpr size_t WS_H = WS_OCAT + al((size_t)T * KCAT * 2);
constexpr size_t WS_X1 = WS_H + al((size_t)T * D * 2);
constexpr size_t WS_DT = WS_X1 + al((size_t)T * D * 4);
constexpr size_t WS_DQK = WS_DT + al((size_t)8192 * 4096 * 2);
constexpr size_t WS_DSC = WS_DQK + al((size_t)8192 * 4096 * 2);
constexpr size_t WS_END = WS_DSC + al((size_t)8192 * 3 * 64 * 4);
static_assert((size_t)2 * RMAX * D * 2 <= (size_t)T * NPROJ * 2, "XBUF|ACT overlay PROJ");
static_assert((size_t)RMAX * D * 2 <= WS_H - WS_CONV, "Y overlays CONV|MIXED|OCAT");
constexpr int CW_BAR = 4096;
constexpr int CW_CNT = 16384;
constexpr int CW_NTILES = 32768;

constexpr int RING_BYTES = 131072;
constexpr int LDS_BYTES = 163840;
constexpr int MISC_OFF = LDS_BYTES - 256;

#define LDS_WAIT() asm volatile("s_waitcnt lgkmcnt(0)" ::: "memory")
#define VM_WAIT() asm volatile("s_waitcnt vmcnt(0)" ::: "memory")
__device__ __forceinline__ unsigned f2bf(float f) { unsigned u = __builtin_bit_cast(unsigned, f); return (u + 0x7fffu + ((u >> 16) & 1u)) >> 16; }
typedef __bf16 bf16x2_t __attribute__((ext_vector_type(2)));
__device__ __forceinline__ unsigned pk2(float lo, float hi) { const f32x2 v = {lo, hi}; const bf16x2_t b = __builtin_convertvector(v, bf16x2_t); return __builtin_bit_cast(unsigned, b); }
constexpr float F8_SX = 32.f, F8_SW = 2048.f, F8_SA = 4.f, F8_SY = 32.f;
__device__ __forceinline__ unsigned pk4_f8(float a, float b, float c, float d) { int w = __builtin_amdgcn_cvt_pk_fp8_f32(a, b, 0, false); w = __builtin_amdgcn_cvt_pk_fp8_f32(c, d, w, true); return (unsigned)w; }
__device__ __forceinline__ f32x4 f8x4(unsigned u) { const f32x2 lo = __builtin_amdgcn_cvt_pk_f32_fp8((int)u, false), hi = __builtin_amdgcn_cvt_pk_f32_fp8((int)u, true); return (f32x4){lo.x, lo.y, hi.x, hi.y}; }
__device__ __forceinline__ float bflo(unsigned u) { return __builtin_bit_cast(float, u << 16); }
__device__ __forceinline__ float bfhi(unsigned u) { return __builtin_bit_cast(float, u & 0xffff0000u); }
__device__ __forceinline__ float wave_sum(float v) {
#pragma unroll
    for (int o = 1; o < 64; o <<= 1) v += __shfl_xor(v, o);
    return v;
}
template <int CTRL> __device__ __forceinline__ float dppf(float v) { return __builtin_bit_cast(float, __builtin_amdgcn_update_dpp(0, __builtin_bit_cast(int, v), CTRL, 0xF, 0xF, true)); }
__device__ __forceinline__ float sigmoidf_(float x) { return __builtin_amdgcn_rcpf(1.0f + __expf(-x)); }

namespace pg8 {
#define PG8_LAS __attribute__((address_space(3)))
constexpr int BM = 256, BK = 64, HALF = 128, HTB = HALF * BK * 2, STAGE_BYTES = 8 * HTB, NXCD = 8, WGM = 8;
__host__ __device__ __forceinline__ int lds_byte(int r, int c) { const int st = (r >> 4) * 2 + (c >> 5), rr = r & 15, cc = c & 31, ob = rr * 64 + cc * 2; return st * 1024 + (ob ^ (((ob >> 9) & 1) << 5)); }
__host__ __device__ __forceinline__ void stage_rc(int b, int& R, int& C) { const int st = b / 1024, sb = b % 1024, swz = sb ^ (((sb >> 9) & 1) << 5); R = (st >> 1) * 16 + swz / 64; C = (st & 1) * 32 + (swz % 64) / 2; }
__host__ __device__ __forceinline__ int perm32(int rho) { const int n = rho >> 4, i = rho & 15; return 8 * (i >> 2) + 4 * n + (i & 3); }
struct Unit { int pm, pn, part; };
template <int N> __device__ __forceinline__ void wait_l() { static_assert(N >= 0 && N < 16, "lgkmcnt"); asm volatile("s_waitcnt lgkmcnt(%0)" :: "n"(N) : "memory"); }
__device__ __forceinline__ void wait_l_n(int n) {
    switch (n) { case 0: wait_l<0>(); break; case 1: wait_l<1>(); break; case 2: wait_l<2>(); break; case 3: wait_l<3>(); break; case 4: wait_l<4>(); break; case 5: wait_l<5>(); break; case 6: wait_l<6>(); break;
                 case 7: wait_l<7>(); break; case 8: wait_l<8>(); break; case 9: wait_l<9>(); break; case 10: wait_l<10>(); break; case 11: wait_l<11>(); break; case 12: wait_l<12>(); break; default: wait_l<0>(); break; } }

template <int MODE> struct Sched {
    static constexpr bool GATHER = (MODE == 4);
    int nM, nN, nwg, G, c, ntk; const char* A; const char* B; size_t tA, tB; const PG8_LAS int* tile_e  ; size_t estride; const int* rowtok; const PG8_LAS int* tbase  ; unsigned tokmax; size_t bdelta1  ;
    __device__ __forceinline__ void init(int nM_, int nN_, int G_, int c_, int ntk_) { nM = nM_; nN = nN_; nwg = nM * nN; G = G_; c = c_; ntk = ntk_; }
    __device__ __forceinline__ bool next(int i, Unit& u) const {
        u.part = (MODE == 3) ? (i & 1) : 0;
        const long L = (long)((MODE == 3) ? (i >> 1) : i) * G + c; if (L >= nwg) return false;
        int wgid = (int)L; { const int q = nwg / NXCD, r = nwg % NXCD, xcd = wgid % NXCD, off = wgid / NXCD; wgid = (xcd < r ? xcd * (q + 1) : r * (q + 1) + (xcd - r) * q) + off; }
        const int nig = WGM * nN, gid = wgid / nig, fm = gid * WGM, gsz = (nM - fm) < WGM ? (nM - fm) : WGM;
        u.pm = fm + ((wgid % nig) % gsz); u.pn = (wgid % nig) / gsz; return true;
    }
    __device__ __forceinline__ int nt(const Unit& u) const { return (MODE == 3) ? (u.part ? 32 : 64) : ntk; }
    __device__ __forceinline__ const char* a_ptr(const Unit& u) const { if (MODE == 4) return A; const char* p = A + (size_t)u.pm * tA; if (MODE == 1) p += (size_t)(u.pn >> 1) * 1024; if (MODE == 3) p += (size_t)u.part * 8192; return p; }
    __device__ __forceinline__ const char* b_ptr(const Unit& u) const { const char* p = B + (size_t)u.pn * tB; if (MODE == 2 || MODE == 4) p += (size_t)tile_e[u.pm] * estride; if (MODE == 3) p += (size_t)u.part * (8192 + bdelta1); return p; }
};

typedef int v8i_t __attribute__((ext_vector_type(8)));
typedef int v4i_t __attribute__((ext_vector_type(4)));
__device__ __forceinline__ v8i_t cat16(bf16x8 a, bf16x8 b) { return __builtin_shufflevector(__builtin_bit_cast(v4i_t, a), __builtin_bit_cast(v4i_t, b), 0, 1, 2, 3, 4, 5, 6, 7); }
constexpr int P1_N1 = 22, P1_N2 = 7; static_assert(24 * P1_N1 + 8 * P1_N2 == 584, "in-projection unit split");
struct SchedP1 {
    static constexpr bool GATHER = false;
    int xcd, j; const char* A; const char* B; size_t tA, tB; const int* rowtok = nullptr; const PG8_LAS int* tbase = nullptr; unsigned tokmax = 0;
    __device__ __forceinline__ bool next(int i, Unit& u) const {
        u.part = 0; int sidx;
        if (j < 24) { if (i >= P1_N1) return false; sidx = 24 * i + j; } else { if (i >= P1_N2) return false; sidx = 24 * P1_N1 + 8 * i + (j - 24); }
        u.pm = 8 * xcd + (sidx & 7); u.pn = sidx >> 3; return true;
    }
    __device__ __forceinline__ int nt(const Unit&) const { return D / 64; }
    __device__ __forceinline__ const char* a_ptr(const Unit& u) const { return A + (size_t)u.pm * tA; }
    __device__ __forceinline__ const char* b_ptr(const Unit& u) const { return B + (size_t)u.pn * tB; }
};
template <class Epi, class Sch, bool ALIGN_EPI, bool SP2, bool F8 = false>
__device__ __forceinline__ void gemm_phase(PG8_LAS unsigned char* lds, const int lda, const int ldb, const Sch& S, const Epi& E) {
    const int tid = threadIdx.x, wid = __builtin_amdgcn_readfirstlane(tid >> 6), lane = tid & 63, wr = wid >> 2, wc = wid & 3, fr = lane & 15, fq = lane >> 4;
    unsigned voffA[2], voffB[2];
#pragma unroll
    for (int i = 0; i < 2; ++i) { int R, C; stage_rc(tid * 16 + i * 8192, R, C); const int Rb = Epi::PERM ? ((R & ~31) + perm32(R & 31)) : R;
        voffA[i] = (unsigned)(R * lda + C) * 2u; voffB[i] = (unsigned)(Rb * ldb + C) * 2u; }
    constexpr bool GATHER = Sch::GATHER; static_assert(!GATHER || SP2, "gather: SP2 loop only");
    unsigned gA[2][2]; int gR[2], gC[2];
    if constexpr (GATHER) {
#pragma unroll
        for (int i = 0; i < 2; ++i) { int R, C; stage_rc(tid * 16 + i * 8192, R, C); gR[i] = R; gC[i] = C * 2; }
    }
#define PG8_RT_LDS(par_) ((const PG8_LAS int*)(lds + STAGE_BYTES + 2048 + ((par_) & 1) * 1024))
#define PG8_RT_DMA(u_, par_) do { if (wid == 0) __builtin_amdgcn_global_load_lds((const unsigned*)(S.rowtok + S.tbase[(u_).pm] + lane * 4), (PG8_LAS unsigned*)(lds + STAGE_BYTES + 2048 + ((par_) & 1) * 1024), 16, 0, 0); } while (0)
#define PG8_RT_PICK(par_) do { _Pragma("unroll") for (int h_ = 0; h_ < 2; ++h_) _Pragma("unroll") for (int i_ = 0; i_ < 2; ++i_) { const unsigned tk_ = (unsigned)PG8_RT_LDS(par_)[gR[i_] + 128 * h_]; gA[h_][i_] = (tk_ < S.tokmax ? tk_ : S.tokmax) * (unsigned)(lda * 2) + (unsigned)gC[i_]; } } while (0)
    const size_t kstep = (size_t)(BK * 2);
    const size_t hstepA = GATHER ? (size_t)0 : (size_t)HALF * lda * 2, hstepB = (size_t)HALF * ldb * 2;
    const unsigned ldsw = (unsigned)wid * 1024u;
    const int aoff = lds_byte(wr * 64 + fr, fq * 8), boff = lds_byte(wc * 32 + fr, fq * 8);
#define PG8_SA(b, h) (((b) * 2 + (h)) * HTB)
#define PG8_SB(b, h) ((4 + (b) * 2 + (h)) * HTB)
#define PG8_STAGE(bufoff, gbase, voff) do { _Pragma("unroll") for (int _i = 0; _i < 2; ++_i) \
        __builtin_amdgcn_global_load_lds((const unsigned*)((const char*)(gbase) + (voff)[_i]), (PG8_LAS unsigned*)(lds + (bufoff) + ldsw + _i * 8192), 16, 0, 0); } while (0)
#define PG8_STAGE_A(b, h, kp) do { if constexpr (GATHER) PG8_STAGE(PG8_SA(b, h), (kp), gA[h]); else PG8_STAGE(PG8_SA(b, h), (kp) + (h) * hstepA, voffA); } while (0)
#define PG8_LDA(dst, b, h) do { if constexpr (F8) { _Pragma("unroll") for (int m = 0; m < 4; ++m) { dst##8[m].lo = *(const PG8_LAS v4i_t*)(lds + PG8_SA(b, h) + aoff + m * 2048); dst##8[m].hi = *(const PG8_LAS v4i_t*)(lds + PG8_SA(b, h) + aoff + m * 2048 + 1024); } } else { \
        _Pragma("unroll") for (int m = 0; m < 4; ++m) _Pragma("unroll") for (int k = 0; k < 2; ++k) dst[m][k] = *(const PG8_LAS bf16x8*)(lds + PG8_SA(b, h) + aoff + m * 2048 + k * 1024); } } while (0)
#define PG8_LDB(dst, b, h) do { if constexpr (F8) { _Pragma("unroll") for (int n = 0; n < 2; ++n) { dst##8[n].lo = *(const PG8_LAS v4i_t*)(lds + PG8_SB(b, h) + boff + n * 2048); dst##8[n].hi = *(const PG8_LAS v4i_t*)(lds + PG8_SB(b, h) + boff + n * 2048 + 1024); } } else { \
        _Pragma("unroll") for (int n = 0; n < 2; ++n) _Pragma("unroll") for (int k = 0; k < 2; ++k) dst[n][k] = *(const PG8_LAS bf16x8*)(lds + PG8_SB(b, h) + boff + n * 2048 + k * 1024); } } while (0)
#define PG8_MMA(ai, bj, At, Bt) do { __builtin_amdgcn_s_setprio(1); if constexpr (F8) { _Pragma("unroll") for (int m = 0; m < 4; ++m) _Pragma("unroll") for (int n = 0; n < 2; ++n) \
        asm volatile("v_mfma_scale_f32_16x16x128_f8f6f4 %0, %1, %2, %0, %3, %3 op_sel_hi:[0,0,0]" : "+v"(acc[ai][bj][m][n]) : "v"(Bt##8[n]), "v"(At##8[m]), "v"(f8scale)); } else { \
        _Pragma("unroll") for (int m = 0; m < 4; ++m) _Pragma("unroll") for (int n = 0; n < 2; ++n) _Pragma("unroll") for (int k = 0; k < 2; ++k) \
        acc[ai][bj][m][n] = __builtin_amdgcn_mfma_f32_16x16x32_bf16(Bt[n][k], At[m][k], acc[ai][bj][m][n], 0, 0, 0); } __builtin_amdgcn_s_setprio(0); } while (0)
#define PG8_WAIT_V(n) asm volatile("s_waitcnt vmcnt(" #n ")" ::: "memory")
#define PG8_WAIT_L(n) asm volatile("s_waitcnt lgkmcnt(" #n ")" ::: "memory")
#define PG8_BAR __builtin_amdgcn_s_barrier()
#define PG8_SCHED __builtin_amdgcn_sched_barrier(0)
    Unit cur, nxt; int ui = 0;
    if (!S.next(0, cur)) return;
    f32x4 acc[2][2][4][2];
#pragma unroll
    for (int a = 0; a < 2; ++a)
#pragma unroll
        for (int b = 0; b < 2; ++b)
#pragma unroll
            for (int m = 0; m < 4; ++m)
#pragma unroll
                for (int n = 0; n < 2; ++n) acc[a][b][m][n] = (f32x4){0.f, 0.f, 0.f, 0.f};
    bf16x8 At[4][2], B0[2][2], B1[2][2]; v8i_t At8[4], B08[2], B18[2]; int f8scale = 0x7F7F7F7F; asm volatile("" : "+v"(f8scale));
    const char* cA = S.a_ptr(cur); const char* cB = S.b_ptr(cur);
#define PG8_BIAS_DMA(u_, ui_) do { if constexpr (Epi::LDS_BIAS) { if (wid == 0) __builtin_amdgcn_global_load_lds((const unsigned*)(E.bias_src(u_) + lane * 4), (PG8_LAS unsigned*)(lds + STAGE_BYTES + ((ui_) & 1) * 1024), 16, 0, 0); } } while (0)
    if constexpr (GATHER) { PG8_RT_DMA(cur, 0); PG8_WAIT_V(0); PG8_BAR; PG8_RT_PICK(0); PG8_WAIT_L(0); }
    PG8_BIAS_DMA(cur, 0);
    if constexpr (SP2) {
        PG8_STAGE(PG8_SB(0, 0), cB, voffB); PG8_STAGE(PG8_SB(0, 1), cB + hstepB, voffB); PG8_STAGE_A(0, 0, cA); PG8_STAGE_A(0, 1, cA);
        if (wr == 1) PG8_BAR;
        PG8_WAIT_V(2); PG8_BAR;
        PG8_STAGE(PG8_SB(1, 0), cB + kstep, voffB); PG8_STAGE_A(1, 0, cA + kstep); PG8_STAGE(PG8_SB(1, 1), cB + hstepB + kstep, voffB);
        PG8_WAIT_V(6); PG8_BAR;
    } else {
        PG8_STAGE(PG8_SB(0, 0), cB, voffB); PG8_STAGE(PG8_SA(0, 0), cA, voffA); PG8_STAGE(PG8_SB(0, 1), cB + hstepB, voffB); PG8_STAGE(PG8_SA(0, 1), cA + hstepA, voffA);
        if (wr == 1) PG8_BAR;
        PG8_WAIT_V(4); PG8_BAR;
        PG8_STAGE(PG8_SB(1, 0), cB + kstep, voffB); PG8_STAGE(PG8_SA(1, 0), cA + kstep, voffA); PG8_STAGE(PG8_SB(1, 1), cB + hstepB + kstep, voffB);
        PG8_WAIT_V(6); PG8_BAR;
    }
    for (;;) {
        const bool has_next = S.next(ui + 1, nxt);
        const char* nA = has_next ? S.a_ptr(nxt) : cA; const char* nB = has_next ? S.b_ptr(nxt) : cB;
        if constexpr (GATHER) { if (has_next) PG8_RT_DMA(nxt, ui + 1); }
        const int nt = S.nt(cur);
        for (int t = 0; t < nt; t += 2) {
            const bool last = (t == nt - 2);
            const char* a1 = cA + (size_t)(t + 1) * kstep;
            const char* a2 = last ? nA : cA + (size_t)(t + 2) * kstep; const char* b2 = last ? nB : cB + (size_t)(t + 2) * kstep;
            const char* a3 = a2 + kstep; const char* b3 = b2 + kstep;
            if constexpr (SP2) {
            PG8_LDB(B0, 0, 0); PG8_LDB(B1, 0, 1); PG8_SCHED; PG8_LDA(At, 0, 0); PG8_STAGE_A(1, 1, a1);
            if constexpr (GATHER) { if (last && has_next) PG8_RT_PICK(ui + 1); }
            PG8_WAIT_V(8); PG8_WAIT_L(0); PG8_BAR; PG8_MMA(0, 0, At, B0); PG8_MMA(0, 1, At, B1); PG8_BAR; PG8_SCHED;
            PG8_LDA(At, 0, 1); PG8_STAGE(PG8_SB(0, 0), b2, voffB); PG8_STAGE(PG8_SB(0, 1), b2 + hstepB, voffB); PG8_STAGE_A(0, 0, a2);
            PG8_WAIT_V(8); PG8_WAIT_L(0); PG8_BAR; PG8_MMA(1, 0, At, B0); PG8_MMA(1, 1, At, B1); PG8_BAR; PG8_SCHED;
            PG8_LDB(B0, 1, 0); PG8_LDB(B1, 1, 1); PG8_SCHED; PG8_LDA(At, 1, 0); PG8_STAGE_A(0, 1, a2);
            PG8_WAIT_V(8); PG8_WAIT_L(0); PG8_BAR; PG8_MMA(0, 0, At, B0); PG8_MMA(0, 1, At, B1); PG8_BAR; PG8_SCHED;
            PG8_LDA(At, 1, 1); PG8_STAGE(PG8_SB(1, 0), b3, voffB); PG8_STAGE(PG8_SB(1, 1), b3 + hstepB, voffB); PG8_STAGE_A(1, 0, a3);
            PG8_WAIT_V(8); PG8_WAIT_L(0); PG8_BAR; PG8_MMA(1, 0, At, B0); PG8_MMA(1, 1, At, B1); PG8_BAR; PG8_SCHED;
            } else {
            PG8_LDB(B0, 0, 0); PG8_SCHED; PG8_LDA(At, 0, 0); PG8_STAGE(PG8_SA(1, 1), a1 + hstepA, voffA);
            PG8_WAIT_L(8); PG8_BAR; PG8_WAIT_L(0); PG8_MMA(0, 0, At, B0); PG8_BAR; PG8_SCHED;
            PG8_LDB(B1, 0, 1); PG8_STAGE(PG8_SB(0, 0), b2, voffB);
            PG8_BAR; PG8_WAIT_L(0); PG8_MMA(0, 1, At, B1); PG8_BAR;
            PG8_LDA(At, 0, 1); PG8_STAGE(PG8_SA(0, 0), a2, voffA);
            PG8_BAR; PG8_WAIT_L(0); PG8_MMA(1, 0, At, B0); PG8_BAR; PG8_SCHED;
            PG8_STAGE(PG8_SB(0, 1), b2 + hstepB, voffB);
            PG8_WAIT_V(6); PG8_BAR; PG8_MMA(1, 1, At, B1); PG8_BAR;
            PG8_LDB(B0, 1, 0); PG8_SCHED; PG8_LDA(At, 1, 0); PG8_STAGE(PG8_SA(0, 1), a2 + hstepA, voffA);
            PG8_WAIT_L(8); PG8_BAR; PG8_WAIT_L(0); PG8_MMA(0, 0, At, B0); PG8_BAR; PG8_SCHED;
            PG8_LDB(B1, 1, 1); PG8_STAGE(PG8_SB(1, 0), b3, voffB);
            PG8_BAR; PG8_WAIT_L(0); PG8_MMA(0, 1, At, B1); PG8_BAR;
            PG8_LDA(At, 1, 1); PG8_STAGE(PG8_SA(1, 0), a3, voffA);
            PG8_BAR; PG8_WAIT_L(0); PG8_MMA(1, 0, At, B0); PG8_BAR; PG8_SCHED;
            PG8_STAGE(PG8_SB(1, 1), b3 + hstepB, voffB);
            PG8_WAIT_V(6); PG8_BAR; PG8_MMA(1, 1, At, B1); PG8_BAR;
            }
        }
        if constexpr (ALIGN_EPI) { if (wr == 0) PG8_BAR; }
        if constexpr (F8) asm volatile("s_nop 15\n\ts_nop 15" ::: "memory");
        E(acc, cur, wr, wc, fr, fq, (const PG8_LAS float*)(lds + STAGE_BYTES + (ui & 1) * 1024));
        if (!has_next) break;
        if (!Epi::SELF_ZERO && !E.keep(cur)) {
#pragma unroll
        for (int a = 0; a < 2; ++a)
#pragma unroll
            for (int b = 0; b < 2; ++b)
#pragma unroll
                for (int m = 0; m < 4; ++m)
#pragma unroll
                    for (int n = 0; n < 2; ++n) acc[a][b][m][n] = (f32x4){0.f, 0.f, 0.f, 0.f};
        }
        cur = nxt; cA = nA; cB = nB; ++ui;
        PG8_BIAS_DMA(cur, ui);
        if constexpr (ALIGN_EPI) { if (wr == 1) PG8_BAR; }
    }
    PG8_WAIT_V(0);
    if constexpr (!ALIGN_EPI) { if (wr == 0) PG8_BAR; }
    PG8_BAR;
#undef PG8_BIAS_DMA
#undef PG8_SA
#undef PG8_SB
#undef PG8_STAGE
#undef PG8_STAGE_A
#undef PG8_RT_LDS
#undef PG8_RT_DMA
#undef PG8_RT_PICK
#undef PG8_LDA
#undef PG8_LDB
#undef PG8_MMA
#undef PG8_WAIT_V
#undef PG8_WAIT_L
#undef PG8_BAR
#undef PG8_SCHED
}

#define ACC_T f32x4 (&acc)[2][2][4][2]
#define EPI_ZERO(ai_, m_) do { acc[ai_][0][m_][0] = (f32x4){0.f, 0.f, 0.f, 0.f}; acc[ai_][0][m_][1] = (f32x4){0.f, 0.f, 0.f, 0.f}; acc[ai_][1][m_][0] = (f32x4){0.f, 0.f, 0.f, 0.f}; acc[ai_][1][m_][1] = (f32x4){0.f, 0.f, 0.f, 0.f}; __builtin_amdgcn_sched_barrier(0); } while (0)
struct EpiProj {
    static constexpr bool PERM = true; static constexpr bool LDS_BIAS = false; static constexpr bool SELF_ZERO = true;
    bf16* O; float* AB;
    __device__ __forceinline__ bool keep(const Unit&) const { return false; }
    __device__ __forceinline__ void operator()(ACC_T, const Unit& u, int wr, int wc, int fr, int fq, const PG8_LAS float* blds) const {
        const int row0 = u.pm * BM + wr * 64 + fr;
        if (u.pn < 72) {
            const int col0 = u.pn * BM + wc * 32 + 8 * fq;
#pragma unroll
            for (int ai = 0; ai < 2; ++ai)
#pragma unroll
                for (int m = 0; m < 4; ++m) { bf16* rowp = O + (size_t)(row0 + ai * HALF + m * 16) * NPROJ + col0;
#pragma unroll
                    for (int bj = 0; bj < 2; ++bj) { const f32x4 v0 = acc[ai][bj][m][0], v1 = acc[ai][bj][m][1];
                        v4u w; w.x = pk2(v0[0], v0[1]); w.y = pk2(v0[2], v0[3]); w.z = pk2(v1[0], v1[1]); w.w = pk2(v1[2], v1[3]);
                        *(v4u*)(rowp + bj * HALF) = w; }
                    EPI_ZERO(ai, m); }
        } else {
            const int col0 = wc * 32 + 8 * fq;
#pragma unroll
            for (int ai = 0; ai < 2; ++ai)
#pragma unroll
                for (int m = 0; m < 4; ++m) { float* rowp = AB + (size_t)(row0 + ai * HALF + m * 16) * 256 + col0;
#pragma unroll
                    for (int bj = 0; bj < 2; ++bj) { *(f32x4*)(rowp + bj * HALF) = acc[ai][bj][m][0]; *(f32x4*)(rowp + bj * HALF + 4) = acc[ai][bj][m][1]; }
                    EPI_ZERO(ai, m); }
        }
    }
};
struct EpiPool {
    static constexpr bool PERM = true; static constexpr bool LDS_BIAS = false; static constexpr bool SELF_ZERO = false;
    bf16* O; const float* scale;
    __device__ __forceinline__ bool keep(const Unit&) const { return false; }
    __device__ __forceinline__ void operator()(ACC_T, const Unit& u, int wr, int wc, int fr, int fq, const PG8_LAS float* blds) const {
        const int row0 = u.pm * BM + wr * 64 + fr, col0 = u.pn * BM + wc * 32 + 8 * fq;
        f32x4 sv[2][2];
#pragma unroll
        for (int bj = 0; bj < 2; ++bj)
#pragma unroll
            for (int n = 0; n < 2; ++n) sv[bj][n] = *(const f32x4*)(scale + col0 + bj * HALF + 4 * n);
#pragma unroll
        for (int ai = 0; ai < 2; ++ai)
#pragma unroll
            for (int m = 0; m < 4; ++m) { bf16* rowp = O + (size_t)(row0 + ai * HALF + m * 16) * KCAT + 4096 + col0;
#pragma unroll
                for (int bj = 0; bj < 2; ++bj) { const f32x4 v0 = acc[ai][bj][m][0] * sv[bj][0], v1 = acc[ai][bj][m][1] * sv[bj][1];
                    v4u w; w.x = pk2(v0[0], v0[1]); w.y = pk2(v0[2], v0[3]); w.z = pk2(v1[0], v1[1]); w.w = pk2(v1[2], v1[3]);
                    *(v4u*)(rowp + bj * HALF) = w; } }
    }
};
struct EpiFold {
    static constexpr bool PERM = true; static constexpr bool LDS_BIAS = false; static constexpr bool SELF_ZERO = true;
    bf16* O;
    __device__ __forceinline__ bool keep(const Unit&) const { return false; }
    __device__ __forceinline__ void operator()(ACC_T, const Unit& u, int wr, int wc, int fr, int fq, const PG8_LAS float* blds) const {
        const int row0 = u.pm * BM + wr * 64 + fr, col0 = u.pn * BM + wc * 32 + 8 * fq;
#pragma unroll
        for (int ai = 0; ai < 2; ++ai)
#pragma unroll
            for (int m = 0; m < 4; ++m) { bf16* rowp = O + (size_t)(row0 + ai * HALF + m * 16) * KCAT + 4096 + col0;
#pragma unroll
                for (int bj = 0; bj < 2; ++bj) { const f32x4 v0 = acc[ai][bj][m][0], v1 = acc[ai][bj][m][1];
                    v4u w; w.x = pk2(v0[0], v0[1]); w.y = pk2(v0[2], v0[3]); w.z = pk2(v1[0], v1[1]); w.w = pk2(v1[2], v1[3]);
                    *(v4u*)(rowp + bj * HALF) = w; }
                EPI_ZERO(ai, m); }
    }
};
struct EpiBranch {
    static constexpr bool PERM = true; static constexpr bool LDS_BIAS = false; static constexpr bool SELF_ZERO = false;
    bf16* Hh; const bf16* PROJ; const float* bgate;
    __device__ __forceinline__ bool keep(const Unit& u) const { return u.part == 0; }
    __device__ __forceinline__ void operator()(ACC_T, const Unit& u, int wr, int wc, int fr, int fq, const PG8_LAS float* blds) const {
        const int row0 = u.pm * BM + wr * 64 + fr, col0 = u.pn * BM + wc * 32 + 8 * fq;
        const f32x2 NL2 = {-1.44269504f, -1.44269504f}, ONE2 = {1.f, 1.f};
#define EB_CL(v) fminf(fmaxf((v), -30.f), 30.f)
        if (u.part == 0) {
#pragma unroll
        for (int bj = 0; bj < 2; ++bj) {
            const f32x4 ba0 = *(const f32x4*)(bgate + col0 + bj * HALF), ba1 = *(const f32x4*)(bgate + col0 + bj * HALF + 4);
            const f32x4 bp0 = *(const f32x4*)(bgate + D + col0 + bj * HALF), bp1 = *(const f32x4*)(bgate + D + col0 + bj * HALF + 4);
            const f32x2 BA[4] = {(f32x2){ba0[0], ba0[1]}, (f32x2){ba0[2], ba0[3]}, (f32x2){ba1[0], ba1[1]}, (f32x2){ba1[2], ba1[3]}};
            const f32x2 BP[4] = {(f32x2){bp0[0], bp0[1]}, (f32x2){bp0[2], bp0[3]}, (f32x2){bp1[0], bp1[1]}, (f32x2){bp1[2], bp1[3]}};
#pragma unroll
            for (int ai = 0; ai < 2; ++ai) {
            v4u gav[4], gpv[4];
#pragma unroll
                for (int m = 0; m < 4; ++m) { const bf16* rowp = PROJ + (size_t)(row0 + ai * HALF + m * 16) * NPROJ + col0 + bj * HALF; gav[m] = *(const v4u*)(rowp + PC_GA); gpv[m] = *(const v4u*)(rowp + PC_GP); }
#pragma unroll
                for (int m = 0; m < 4; ++m) { const v4u ga = gav[m], gp = gpv[m];
#pragma unroll
                    for (int q = 0; q < 4; ++q) {
                        const f32x2 av = (f32x2){bflo(ga[q]), bfhi(ga[q])} + BA[q], pv = (f32x2){bflo(gp[q]), bfhi(gp[q])} + BP[q];
                        const f32x2 ta = (f32x2){EB_CL(av.x), EB_CL(av.y)} * NL2, tp = (f32x2){EB_CL(pv.x), EB_CL(pv.y)} * NL2;
                        const f32x2 da = (f32x2){__builtin_amdgcn_exp2f(ta.x), __builtin_amdgcn_exp2f(ta.y)} + ONE2, dp = (f32x2){__builtin_amdgcn_exp2f(tp.x), __builtin_amdgcn_exp2f(tp.y)} + ONE2;
                        const f32x2 f = dp * (f32x2){__builtin_amdgcn_rcpf(da.x), __builtin_amdgcn_rcpf(da.y)};
                        f32x4& A = acc[ai][bj][m][q >> 1]; const f32x2 v = (f32x2){A[2 * (q & 1)], A[2 * (q & 1) + 1]} * f; A[2 * (q & 1)] = v.x; A[2 * (q & 1) + 1] = v.y; } }
            asm volatile("" ::: "memory");
            }
        }
        } else {
#pragma unroll
        for (int bj = 0; bj < 2; ++bj) {
            const f32x4 bp0 = *(const f32x4*)(bgate + D + col0 + bj * HALF), bp1 = *(const f32x4*)(bgate + D + col0 + bj * HALF + 4);
            const f32x2 BP[4] = {(f32x2){bp0[0], bp0[1]}, (f32x2){bp0[2], bp0[3]}, (f32x2){bp1[0], bp1[1]}, (f32x2){bp1[2], bp1[3]}};
            v4u gpv[2][4];
#pragma unroll
            for (int ai = 0; ai < 2; ++ai)
#pragma unroll
                for (int m = 0; m < 4; ++m) gpv[ai][m] = *(const v4u*)(PROJ + (size_t)(row0 + ai * HALF + m * 16) * NPROJ + PC_GP + col0 + bj * HALF);
#pragma unroll
            for (int ai = 0; ai < 2; ++ai)
#pragma unroll
                for (int m = 0; m < 4; ++m) { const size_t r = (size_t)(row0 + ai * HALF + m * 16); const v4u gp = gpv[ai][m]; v4u w;
#pragma unroll
                    for (int q = 0; q < 4; ++q) {
                        const f32x2 pv = (f32x2){bflo(gp[q]), bfhi(gp[q])} + BP[q];
                        const f32x2 tp = (f32x2){EB_CL(pv.x), EB_CL(pv.y)} * NL2;
                        const f32x2 dp = (f32x2){__builtin_amdgcn_exp2f(tp.x), __builtin_amdgcn_exp2f(tp.y)} + ONE2;
                        const f32x4 A = acc[ai][bj][m][q >> 1]; const f32x2 v = (f32x2){A[2 * (q & 1)], A[2 * (q & 1) + 1]} * (f32x2){__builtin_amdgcn_rcpf(dp.x), __builtin_amdgcn_rcpf(dp.y)};
                        w[q] = pk2(v.x, v.y); }
                    *(v4u*)(Hh + r * D + col0 + bj * HALF) = w; }
            asm volatile("" ::: "memory");
        }
        }
#undef EB_CL
    }
};
struct EpiOut {
    static constexpr bool PERM = true; static constexpr bool LDS_BIAS = false; static constexpr bool SELF_ZERO = true;
    const float* X; bf16* X1;
    __device__ __forceinline__ bool keep(const Unit&) const { return false; }
    __device__ __forceinline__ void operator()(ACC_T, const Unit& u, int wr, int wc, int fr, int fq, const PG8_LAS float* blds) const {
        const size_t ubase = (size_t)(u.pm * BM + wr * 64) * D + u.pn * BM + wc * 32;
        const char* xb = (const char*)(X + ubase); char* ob = (char*)(X1 + ubase);
        const unsigned lx = (unsigned)(fr * D + 8 * fq) * 4u, lo = (unsigned)(fr * D + 8 * fq) * 2u;
#pragma unroll
        for (int ai = 0; ai < 2; ++ai) {
            f32x4 xv[4][2][2];
#pragma unroll
            for (int m = 0; m < 4; ++m)
#pragma unroll
                for (int bj = 0; bj < 2; ++bj)
#pragma unroll
                    for (int n = 0; n < 2; ++n) xv[m][bj][n] = *(const f32x4*)(xb + ((size_t)(ai * HALF + m * 16) * D + bj * HALF + n * 4) * 4 + lx);
#pragma unroll
            for (int m = 0; m < 4; ++m)
#pragma unroll
                for (int bj = 0; bj < 2; ++bj) { const f32x4 v0 = xv[m][bj][0] + acc[ai][bj][m][0], v1 = xv[m][bj][1] + acc[ai][bj][m][1];
                    v4u w; w.x = pk2(v0[0], v0[1]); w.y = pk2(v0[2], v0[3]); w.z = pk2(v1[0], v1[1]); w.w = pk2(v1[2], v1[3]);
                    *(v4u*)(ob + ((size_t)(ai * HALF + m * 16) * D + bj * HALF) * 2 + lo) = w;
                    if (bj == 1) EPI_ZERO(ai, m); }
            asm volatile("" ::: "memory");
        }
    }
};
__device__ __forceinline__ v4u widen16(v2u a, v2u b) {
    const auto rx = __builtin_amdgcn_permlane16_swap(a.x, b.x, false, false); const auto ry = __builtin_amdgcn_permlane16_swap(a.y, b.y, false, false);
    return (v4u){rx[0], ry[0], rx[1], ry[1]};
}
struct EpiSwiglu {
    static constexpr bool PERM = false; static constexpr bool LDS_BIAS = true; static constexpr bool SELF_ZERO = true;
    unsigned char* ACT; const float* b1; const PG8_LAS int* tile_e;
    __device__ __forceinline__ const float* bias_src(const Unit& u) const { return b1 + (size_t)tile_e[u.pm] * (2 * DE) + u.pn * 256; }
    __device__ __forceinline__ bool keep(const Unit&) const { return false; }
    __device__ __forceinline__ void operator()(ACC_T, const Unit& u, int wr, int wc, int fr, int fq, const PG8_LAS float* blds) const {
        const int row0 = u.pm * BM + wr * 64 + fr, o0 = u.pn * 128 + wc * 32 + 8 * fq;
        const PG8_LAS float* bb = blds + 2 * (wc * 32 + 8 * fq);
        const f32x4 q0 = *(const PG8_LAS f32x4*)(bb), q1 = *(const PG8_LAS f32x4*)(bb + 4), q2 = *(const PG8_LAS f32x4*)(bb + 8), q3 = *(const PG8_LAS f32x4*)(bb + 12);
        const f32x4 bg[2] = {(f32x4){q0[0], q0[2], q1[0], q1[2]}, (f32x4){q2[0], q2[2], q3[0], q3[2]}};
        const f32x4 bl[2] = {(f32x4){q0[1], q0[3], q1[1], q1[3]}, (f32x4){q2[1], q2[3], q3[1], q3[3]}};
        const f32x2 S2 = {1.f / (F8_SX * F8_SW), 1.f / (F8_SX * F8_SW)}, C2 = {-1.702f * 1.44269504f, -1.702f * 1.44269504f}, ONE2 = {1.f, 1.f}, SA2 = {F8_SA, F8_SA};
        const int odd = fq & 1;
#pragma unroll
        for (int ai = 0; ai < 2; ++ai)
#pragma unroll
            for (int mp = 0; mp < 2; ++mp) { v2u wq[2];
#pragma unroll
            for (int mm = 0; mm < 2; ++mm) { const int m = 2 * mp + mm; f32x2 r[2][2];
#pragma unroll
                for (int bj = 0; bj < 2; ++bj) { const f32x4 A0 = acc[ai][bj][m][0], A1 = acc[ai][bj][m][1];
#pragma unroll
                    for (int h = 0; h < 2; ++h) {
                        const f32x2 g = (f32x2){A0[2 * h], A0[2 * h + 1]} * S2 + (f32x2){bg[bj][2 * h], bg[bj][2 * h + 1]}, l = (f32x2){A1[2 * h], A1[2 * h + 1]} * S2 + (f32x2){bl[bj][2 * h], bl[bj][2 * h + 1]};
                        const f32x2 xg = {fminf(g.x, 7.0f), fminf(g.y, 7.0f)}, xl = {fminf(fmaxf(l.x, -7.0f), 7.0f), fminf(fmaxf(l.y, -7.0f), 7.0f)};
                        const f32x2 t = xg * C2; const f32x2 d = (f32x2){__builtin_amdgcn_exp2f(t.x), __builtin_amdgcn_exp2f(t.y)} + ONE2;
                        const f32x2 rc = {__builtin_amdgcn_rcpf(d.x), __builtin_amdgcn_rcpf(d.y)};
                        r[bj][h] = (xg * rc) * (xl * SA2 + SA2); } }
                wq[mm].x = pk4_f8(r[0][0].x, r[0][0].y, r[0][1].x, r[0][1].y); wq[mm].y = pk4_f8(r[1][0].x, r[1][0].y, r[1][1].x, r[1][1].y); }
                *(v4u*)(ACT + (size_t)(row0 + ai * HALF + (2 * mp + odd) * 16) * DE + o0 - 8 * odd) = widen16(wq[0], wq[1]);
                EPI_ZERO(ai, 2 * mp); EPI_ZERO(ai, 2 * mp + 1); }
    }
};
struct EpiY {
    static constexpr bool PERM = true; static constexpr bool LDS_BIAS = true; static constexpr bool SELF_ZERO = true;
    unsigned char* Y; const float* b2; const PG8_LAS int* tile_e;
    __device__ __forceinline__ const float* bias_src(const Unit& u) const { return b2 + (size_t)tile_e[u.pm] * D + u.pn * 256; }
    __device__ __forceinline__ bool keep(const Unit&) const { return false; }
    __device__ __forceinline__ void operator()(ACC_T, const Unit& u, int wr, int wc, int fr, int fq, const PG8_LAS float* blds) const {
        const int row0 = u.pm * BM + wr * 64 + fr, col0 = u.pn * BM + wc * 32 + 8 * fq;
        const PG8_LAS float* bb = blds + wc * 32 + 8 * fq;
        f32x4 bv[2][2];
#pragma unroll
        for (int bj = 0; bj < 2; ++bj)
#pragma unroll
            for (int n = 0; n < 2; ++n) bv[bj][n] = *(const PG8_LAS f32x4*)(bb + bj * HALF + 4 * n) * F8_SY;
        const int odd = fq & 1;
#pragma unroll
        for (int ai = 0; ai < 2; ++ai)
#pragma unroll
            for (int mp = 0; mp < 2; ++mp) { v2u wq[2][2];
#pragma unroll
                for (int mm = 0; mm < 2; ++mm)
#pragma unroll
                    for (int bj = 0; bj < 2; ++bj) { const int m = 2 * mp + mm; const f32x4 v0 = acc[ai][bj][m][0] * (F8_SY / (F8_SA * F8_SW)) + bv[bj][0], v1 = acc[ai][bj][m][1] * (F8_SY / (F8_SA * F8_SW)) + bv[bj][1];
                        wq[mm][bj].x = pk4_f8(v0[0], v0[1], v0[2], v0[3]); wq[mm][bj].y = pk4_f8(v1[0], v1[1], v1[2], v1[3]); }
                unsigned char* rowp = Y + (size_t)(row0 + ai * HALF + (2 * mp + odd) * 16) * D + col0 - 8 * odd;
#pragma unroll
                for (int bj = 0; bj < 2; ++bj) *(v4u*)(rowp + bj * HALF) = widen16(wq[0][bj], wq[1][bj]);
                EPI_ZERO(ai, 2 * mp); EPI_ZERO(ai, 2 * mp + 1); }
    }
};
}

#define XB_TMO      128
#define XB_XCNT(j)  (256  + 64 * (j))
#define XB_XSUB(j)  (1280 + 64 * (j))
#define XB_XGEN(j)  (2304 + 64 * (j))
#define XB_TOP      3328
#define XB_TOPGEN   3392
#define XCD_BAR_WORDS 3456
#define XB_SPIN_CAP (1u << 18)
__device__ __forceinline__ unsigned xb_ld(unsigned* p)              { return __hip_atomic_load(p, __ATOMIC_RELAXED, __HIP_MEMORY_SCOPE_AGENT); }
__device__ __forceinline__ unsigned xb_add(unsigned* p, unsigned v) { return __hip_atomic_fetch_add(p, v, __ATOMIC_RELAXED, __HIP_MEMORY_SCOPE_AGENT); }
__device__ __forceinline__ unsigned xb_xcc_id() { return (unsigned)__builtin_amdgcn_s_getreg((3 << 11) | 20) & 0xFu; }
#define XB_SPIN(cond, bar) do { unsigned _sp = 0; while (cond) { __builtin_amdgcn_s_sleep(1); \
    if ((++_sp & 255u) == 0u) { if (xb_ld(&(bar)[XB_TMO])) break; if (_sp > XB_SPIN_CAP) { atomicAdd(&(bar)[XB_TMO], 1u); break; } } } } while (0)
struct XcdBarrier { unsigned* bar; unsigned x; volatile LAS unsigned* st; };
__device__ __forceinline__ XcdBarrier xcd_barrier_post(unsigned* bar, volatile LAS unsigned* st) {
    XcdBarrier b; b.bar = bar; b.x = xb_xcc_id(); b.st = st;
    if (threadIdx.x == 0) (void)xb_add(&bar[XB_XCNT(b.x)], 1u);
    return b;
}
__device__ __forceinline__ void xcd_barrier_complete(unsigned* bar, unsigned x, unsigned& nloc, unsigned& nx) {
    const unsigned G = gridDim.x * gridDim.y * gridDim.z;
    unsigned sum, cnt, mine, sp = 0u;
    for (;;) {
        sum = 0u; cnt = 0u; mine = 0u;
#pragma unroll
        for (unsigned j = 0; j < 16; ++j) { const unsigned c = xb_ld(&bar[XB_XCNT(j)]); sum += c; cnt += (c > 0u) ? 1u : 0u; mine = (j == x) ? c : mine; }
        if (sum == G) break;
        __builtin_amdgcn_s_sleep(1);
        if ((++sp & 255u) == 0u) { if (xb_ld(&bar[XB_TMO])) break; if (sp > XB_SPIN_CAP) { atomicAdd(&bar[XB_TMO], 1u); break; } }
    }
    nloc = mine > 0u ? mine : 1u; nx = cnt > 0u ? cnt : 1u;
}
__device__ __forceinline__ void xcd_barrier(const XcdBarrier& b) {
    asm volatile("s_waitcnt vmcnt(0)" ::: "memory");
    __syncthreads();
    if (threadIdx.x == 0) {
        unsigned* bar = b.bar;
        __builtin_amdgcn_s_waitcnt(0);
        unsigned nloc = b.st[0], nx = b.st[1];
        if (nloc == 0u) { xcd_barrier_complete(bar, b.x, nloc, nx); b.st[0] = nloc; b.st[1] = nx; }
        const unsigned old = xb_add(&bar[XB_XSUB(b.x)], 1u);
        const unsigned gen = old / nloc;
        if (old + 1u == (gen + 1u) * nloc) {
            __builtin_amdgcn_fence(__ATOMIC_RELEASE, "agent");
            asm volatile("s_waitcnt vmcnt(0)" ::: "memory");
            const unsigned og = xb_add(&bar[XB_TOP], 1u);
            const unsigned tg = og / nx;
            if (og + 1u == (tg + 1u) * nx) xb_add(&bar[XB_TOPGEN], 1u);
            else XB_SPIN(xb_ld(&bar[XB_TOPGEN]) == tg, bar);
            __builtin_amdgcn_fence(__ATOMIC_ACQUIRE, "agent");
            xb_add(&bar[XB_XGEN(b.x)], 1u);
            asm volatile("s_waitcnt vmcnt(0)" ::: "memory");
        } else {
            XB_SPIN(xb_ld(&bar[XB_XGEN(b.x)]) == gen, bar);
            __builtin_amdgcn_fence(__ATOMIC_ACQUIRE, "agent");
            asm volatile("s_waitcnt vmcnt(0)" ::: "memory");
        }
    }
    __syncthreads();
}

struct Args { const float* in[21]; float* out; unsigned char* ws; int ph_lo, ph_hi; };
struct Frame {
    LAS unsigned char* lds; unsigned* ctl; unsigned char* ws;
    int tid, lane, wave, vcu, G;
};
enum { I_X = 0, I_N1W, I_WIN, I_BGATE, I_CONVW, I_ALOG, I_DTB, I_ONW, I_WBA, I_WPOOL, I_PSCALE, I_WBP, I_WOUT, I_N2W, I_RW, I_RB, I_W1, I_B1, I_W2, I_B2, I_NFW };

template <int MAP> __device__ __forceinline__ int map_row(int n) {
    if (MAP == 1) return n < 12288 ? n : (n < 12352 ? n + 6144 : n - 64);
    if (MAP == 2) { const int nn = n & 1, o = n >> 1; return ((o >> 7) << 8) + (((o >> 2) & 1) << 7) + (((o >> 5) & 3) << 5) + (nn << 4) + (((o >> 3) & 3) << 2) + (o & 3); }
    return n;
}
template <bool F8> __device__ __forceinline__ void tr_load(f32x4 (&v)[16], const float* __restrict__ W, int N, int k0, int n0, int lane) {
    if (F8) { const int kr = lane >> 3, c4 = lane & 7;
#pragma unroll
        for (int i = 0; i < 16; ++i) v[i] = __builtin_nontemporal_load((const f32x4*)(W + (size_t)(k0 + 8 * i + kr) * N + n0 + 4 * c4));
    } else { const int kr = lane >> 4, c4 = lane & 15;
#pragma unroll
        for (int i = 0; i < 16; ++i) v[i] = __builtin_nontemporal_load((const f32x4*)(W + (size_t)(k0 + 4 * i + kr) * N + n0 + 4 * c4)); }
}
template <bool F8> __device__ __forceinline__ void tr_stage(const f32x4 (&v)[16], LAS float* scr, int lane) {
    if (F8) { const int kr = lane >> 3, c4 = lane & 7;
#pragma unroll
        for (int i = 0; i < 16; ++i) { const int k = 8 * i + kr; *(LAS f32x4*)(scr + k * 36 + 4 * (c4 ^ ((k >> 4) & 7))) = v[i]; }
    } else { const int kr = lane >> 4, c4 = lane & 15;
#pragma unroll
        for (int i = 0; i < 16; ++i) { const int k = 4 * i + kr; *(LAS f32x4*)(scr + k * 68 + 4 * (c4 ^ ((k >> 3) & 7))) = v[i]; }
    }
    LDS_WAIT(); asm volatile("" ::: "memory");
}
template <int MAP, bool F8> __device__ __forceinline__ void tr_emit(void* __restrict__ WTv, int ldd, int koff, int row_off, LAS float* scr, int k0, int n0, int lane) {
    if (F8) {
        unsigned char* WT = (unsigned char*)WTv;
#pragma unroll
        for (int x = 0; x < 4; ++x) { const int c = lane & 7, n = (lane >> 3) + 8 * x; const LAS float* s = scr + (16 * c) * 36 + (n ^ (4 * c));
            v4u o; o.x = pk4_f8(s[0 * 36] * F8_SW, s[1 * 36] * F8_SW, s[2 * 36] * F8_SW, s[3 * 36] * F8_SW); o.y = pk4_f8(s[4 * 36] * F8_SW, s[5 * 36] * F8_SW, s[6 * 36] * F8_SW, s[7 * 36] * F8_SW);
            o.z = pk4_f8(s[8 * 36] * F8_SW, s[9 * 36] * F8_SW, s[10 * 36] * F8_SW, s[11 * 36] * F8_SW); o.w = pk4_f8(s[12 * 36] * F8_SW, s[13 * 36] * F8_SW, s[14 * 36] * F8_SW, s[15 * 36] * F8_SW);
            __builtin_nontemporal_store(o, (v4u*)(WT + (size_t)(row_off + map_row<MAP>(n0 + n)) * ldd + koff + k0 + 16 * c)); }
        LDS_WAIT(); asm volatile("" ::: "memory");
    } else {
        bf16* WT = (bf16*)WTv;
        const int c = lane & 7;
#pragma unroll
        for (int j = 0; j < 8; ++j) { const int n = (lane >> 3) + 8 * j; const LAS float* s = scr + (8 * c) * 68 + (n ^ (4 * c));
            v4u o; o.x = pk2(s[0 * 68], s[1 * 68]); o.y = pk2(s[2 * 68], s[3 * 68]); o.z = pk2(s[4 * 68], s[5 * 68]); o.w = pk2(s[6 * 68], s[7 * 68]);
            *(v4u*)(WT + (size_t)(row_off + map_row<MAP>(n0 + n)) * ldd + koff + k0 + 8 * c) = o; }
        LDS_WAIT(); asm volatile("" ::: "memory");
    }
}
template <int MAP, bool F8> __device__ __forceinline__ void tr_matrix(Frame& F, const float* W, int nbatch, size_t src_stride, int K, int N, void* WT, int ldd, int koff, int row_off, int row_stride, int gw, int NGW) {
    LAS float* scr = (LAS float*)(F.lds + F.wave * 18432);
    constexpr int TK = F8 ? 128 : 64, TN = F8 ? 32 : 64;
    const int nnb = N / TN, nit = (K / TK) * nnb, total = nit * nbatch;
#define TR_DECODE(it_, e_, k0_, n0_) const int e_ = (it_) / nit, r_##e_ = (it_) % nit, k0_ = (r_##e_ / nnb) * TK, n0_ = (r_##e_ % nnb) * TN
    f32x4 va[16], vb[16];
    int it = gw;
    if (it >= total) return;
    { const int i0 = it < total ? it : total - 1; TR_DECODE(i0, e0, k0, n0); tr_load<F8>(va, W + (size_t)e0 * src_stride, N, k0, n0, F.lane); }
    { const int i1 = it + NGW < total ? it + NGW : total - 1; TR_DECODE(i1, e0, k0, n0); tr_load<F8>(vb, W + (size_t)e0 * src_stride, N, k0, n0, F.lane); }
#define TR_STEP(cur) { tr_stage<F8>(cur, scr, F.lane); { const int n2 = it + 2 * NGW < total ? it + 2 * NGW : total - 1; TR_DECODE(n2, e1, k1, n1); tr_load<F8>(cur, W + (size_t)e1 * src_stride, N, k1, n1, F.lane); } \
          TR_DECODE(it, e0, k0, n0); tr_emit<MAP, F8>(WT, ldd, koff, row_off + e0 * row_stride, scr, k0, n0, F.lane); it += NGW; }
    while (it < total) {
        TR_STEP(va); if (it >= total) break;
        TR_STEP(vb);
    }
#undef TR_STEP
#undef TR_DECODE
}
__device__ __forceinline__ void p_convert_experts(Frame& F, const Args& a, int gw, int NGW) {
    tr_matrix<2, true>(F, a.in[I_W1], NE, (size_t)D * 2 * DE, D, 2 * DE, (unsigned char*)(F.ws + WS_W1), D, 0, 0, 2 * DE, gw, NGW);
    tr_matrix<0, true>(F, a.in[I_W2], NE, (size_t)DE * D, DE, D, (unsigned char*)(F.ws + WS_W2), DE, 0, 0, D, gw, NGW);
}
__device__ __forceinline__ void p0_prologue(Frame& F, const Args& a) {
    unsigned char* ws = F.ws;
    const int gw0 = F.vcu * 8 + F.wave, NGW0 = F.G * 8;
#define P0_ROT(cnt_) ((gw0 + NGW0 - (int)((cnt_) % NGW0)) % NGW0)
    tr_matrix<1, false>(F, a.in[I_WIN], 1, 0, D, 18496, (bf16*)(ws + WS_WIN), LDX, 0, 0, 0, gw0, NGW0);
    tr_matrix<0, false>(F, a.in[I_WBA], 1, 0, 4096, D, (bf16*)(ws + WS_WCAT), KCAT, 0, 0, 0, P0_ROT(9248), NGW0);
    tr_matrix<0, false>(F, a.in[I_WBP], 1, 0, D, D, (bf16*)(ws + WS_WCAT), KCAT, 4096, 0, 0, P0_ROT(9248 + 2048), NGW0);
    tr_matrix<0, false>(F, a.in[I_WOUT], 1, 0, D, D, (bf16*)(ws + WS_WOUT), D, 0, 0, 0, P0_ROT(9248 + 2048 + 1024), NGW0);
    {
      const float* WP = a.in[I_WPOOL]; const float* PS = a.in[I_PSCALE]; v2u* BW = (v2u*)(ws + WS_WPOOL);
      for (int i4 = (int)blockIdx.x * 512 + F.tid; i4 < 4 * 512 * 512 / 4; i4 += (int)gridDim.x * 512) { const int g = i4 >> 16, e = (i4 * 4) & 511;
          const f32x4 w = *(const f32x4*)(WP + (size_t)i4 * 4) * *(const f32x4*)(PS + g * 512 + e); v2u o; o.x = pk2(w.x, w.y); o.y = pk2(w.z, w.w); BW[i4] = o; } }
#undef P0_ROT
    if (F.G != 256) p_convert_experts(F, a, gw0, NGW0);
    { float* RWT = (float*)(ws + WS_ROUTE + RT_RWT); const float* RW = a.in[I_RW]; const float* N2 = a.in[I_N2W];
      for (int idx = (int)blockIdx.x * 512 + F.tid; idx < NE * D; idx += (int)gridDim.x * 512) { const int e = idx >> 11, d = idx & (D - 1); const float v = RW[(size_t)d * NE + e] * N2[d];
          const unsigned hb = f2bf(v), lb = f2bf(v - __builtin_bit_cast(float, hb << 16)); ((unsigned short*)RWT)[idx] = (unsigned short)hb; ((unsigned short*)RWT)[NE * D + idx] = (unsigned short)lb; } }
    const int gw = F.vcu * 8 + F.wave, NGW = F.G * 8;
    const float* x = a.in[I_X]; const float* w = a.in[I_N1W]; bf16* XN = (bf16*)(ws + WS_XN);
    f32x4 wv[8];
#pragma unroll
    for (int j = 0; j < 8; ++j) wv[j] = *(const f32x4*)(w + 4 * F.lane + 256 * j);
    f32x4 vnx[8];
    { const int m0 = gw < T ? gw : T - 1; const f32x4* xr = (const f32x4*)(x + (size_t)m0 * D) + F.lane;
#pragma unroll
      for (int j = 0; j < 8; ++j) vnx[j] = xr[64 * j]; }
    for (int m = gw; m < T; m += NGW) {
        f32x4 v[8]; float s = 0.f;
#pragma unroll
        for (int j = 0; j < 8; ++j) v[j] = vnx[j];
        { const int m1 = m + NGW < T ? m + NGW : T - 1; const f32x4* xr = (const f32x4*)(x + (size_t)m1 * D) + F.lane;
#pragma unroll
          for (int j = 0; j < 8; ++j) vnx[j] = xr[64 * j]; }
#pragma unroll
        for (int j = 0; j < 8; ++j) s += (v[j].x * v[j].x + v[j].y * v[j].y) + (v[j].z * v[j].z + v[j].w * v[j].w);
        const float rstd = __frsqrt_rn(wave_sum(s) * (1.f / D) + RMS_EPS);
        v2u* o = (v2u*)(XN + (size_t)m * LDX) + F.lane;
#pragma unroll
        for (int j = 0; j < 8; ++j) { const f32x4 y = v[j] * rstd * wv[j]; v2u p; p.x = pk2(y.x, y.y); p.y = pk2(y.z, y.w); o[64 * j] = p; }
    }
}

__device__ __forceinline__ void p2_prep(Frame& F, const Args& a) {
    const bf16* PROJ = (const bf16*)(F.ws + WS_PROJ); bf16* CONV = (bf16*)(F.ws + WS_CONV); bf16* OCATP = (bf16*)(F.ws + WS_OCAT) + 4096;
    const float* cw = a.in[I_CONVW];
    const int gw = F.vcu * 8 + F.wave, NGW = F.G * 8, lane = F.lane;
    constexpr int NCONV = 128 * 16, NPOOLU = 512 * 4;
    for (int it = gw; it < NCONV; it += NGW) {
            const int tb = it >> 4, cb = it & 15, t0 = tb * 128, c0 = cb * 512 + lane * 8, s0 = t0 & (SEQ - 1);
            f32x2 w[4][4];
#pragma unroll
            for (int i = 0; i < 4; ++i) { const f32x4 w0 = *(const f32x4*)(cw + (size_t)i * 8192 + c0), w1 = *(const f32x4*)(cw + (size_t)i * 8192 + c0 + 4);
                w[i][0] = (f32x2){w0[0], w0[1]}; w[i][1] = (f32x2){w0[2], w0[3]}; w[i][2] = (f32x2){w1[0], w1[1]}; w[i][3] = (f32x2){w1[2], w1[3]}; }
            const bf16* src = PROJ + (size_t)t0 * NPROJ + c0;
            v4u ua[8], ub[8];
#pragma unroll
            for (int k = 0; k < 8; ++k) ua[k] = *(const v4u*)(src + (size_t)k * NPROJ);
            f32x2 h0[4], h1[4], h2[4];
#pragma unroll
            for (int q = 0; q < 4; ++q) { h0[q] = (f32x2){0.f, 0.f}; h1[q] = (f32x2){0.f, 0.f}; h2[q] = (f32x2){0.f, 0.f}; }
            if (s0 > 0) {
                const v4u u0 = *(const v4u*)(src - (size_t)3 * NPROJ), u1 = *(const v4u*)(src - (size_t)2 * NPROJ), u2 = *(const v4u*)(src - (size_t)NPROJ);
#pragma unroll
                for (int q = 0; q < 4; ++q) { h0[q] = (f32x2){bflo(u0[q]), bfhi(u0[q])}; h1[q] = (f32x2){bflo(u1[q]), bfhi(u1[q])}; h2[q] = (f32x2){bflo(u2[q]), bfhi(u2[q])}; }
            }
            const float qs = (cb < 4) ? 0.08838834764831845f : 1.0f;
            bf16* cdst; { const int bb = t0 >> 11, hd = (cb & 3) * 4 + (lane >> 4), dd = (lane & 15) * 8;
                cdst = cb < 4 ? CONV + ((size_t)(bb * 16 + hd) * SEQ + s0) * 128 + dd
                     : cb < 8 ? CONV + CONV_K + ((size_t)(bb * 16 + hd) * SEQ + s0) * 128 + dd
                              : CONV + CONV_V + ((size_t)(bb * 32 + (cb - 8) * 4 + (lane >> 4)) * SEQ + s0) * 128 + dd; }
            const f32x2 NL2 = {-1.44269504f, -1.44269504f}, ONE2 = {1.f, 1.f};
#define CV_BATCH(cur, nxt, tt0_) { const int tn_ = (tt0_) + 8 < 128 ? (tt0_) + 8 : (tt0_);        \
            _Pragma("unroll") for (int k = 0; k < 8; ++k) nxt[k] = *(const v4u*)(src + (size_t)(tn_ + k) * NPROJ); \
            _Pragma("unroll") for (int k = 0; k < 8; ++k) { const int tt = (tt0_) + k; const v4u u = cur[k]; \
                f32x2 y[4]; f32x2 ss2 = {0.f, 0.f}; \
                _Pragma("unroll") for (int q = 0; q < 4; ++q) { const f32x2 xc = {bflo(u[q]), bfhi(u[q])}; \
                    const f32x2 z = w[0][q] * h0[q] + w[1][q] * h1[q] + w[2][q] * h2[q] + w[3][q] * xc; const f32x2 t = z * NL2; \
                    const f32x2 d = (f32x2){__builtin_amdgcn_exp2f(t.x), __builtin_amdgcn_exp2f(t.y)} + ONE2; \
                    y[q] = z * (f32x2){__builtin_amdgcn_rcpf(d.x), __builtin_amdgcn_rcpf(d.y)}; ss2 += y[q] * y[q]; h0[q] = h1[q]; h1[q] = h2[q]; h2[q] = xc; } \
                { float ss = ss2.x + ss2.y; ss += dppf<0xB1>(ss); ss += dppf<0x4E>(ss); ss += dppf<0x141>(ss); ss += dppf<0x140>(ss);        \
                    const float inv = cb < 8 ? __frsqrt_rn(ss + L2_EPS) * qs : 1.0f; const f32x2 inv2 = {inv, inv}; \
                    _Pragma("unroll") for (int q = 0; q < 4; ++q) y[q] *= inv2; } \
                v4u o; o.x = pk2(y[0].x, y[0].y); o.y = pk2(y[1].x, y[1].y); o.z = pk2(y[2].x, y[2].y); o.w = pk2(y[3].x, y[3].y); \
                *(v4u*)(cdst + (size_t)tt * 128) = o; } }
            for (int tt0 = 0; tt0 < 128; tt0 += 16) { CV_BATCH(ua, ub, tt0); CV_BATCH(ub, ua, tt0 + 8); }
#undef CV_BATCH
    }
    for (int it = gw; it < NPOOLU; it += NGW) {
            const int tb = it >> 2, gi = it & 3, t0 = tb * 32, s0 = t0 & (SEQ - 1), win = 2 << gi, c0 = gi * 512 + lane * 8;
            const bf16* P = PROJ + PC_P + c0 + (size_t)t0 * NPROJ;
            v4u ua[8], qa[8], ub[8], qb[8];
#define PL_LOAD(u_, q_, tt0_) { _Pragma("unroll") for (int k = 0; k < 8; ++k) { const int tt = (tt0_) + k; u_[k] = *(const v4u*)(P + (size_t)tt * NPROJ); \
                const int tq = (s0 + tt - win >= 0) ? tt - win : tt; q_[k] = *(const v4u*)(P + (ptrdiff_t)tq * NPROJ); } }
            PL_LOAD(ua, qa, 0);
            f32x2 sum[4];
#pragma unroll
            for (int q = 0; q < 4; ++q) sum[q] = (f32x2){0.f, 0.f};
            if (s0 > 0) {
                v4u hb[16];
#pragma unroll
                for (int d = 1; d <= 16; ++d) { const int dd = d <= win ? d : win; hb[d - 1] = *(const v4u*)(P - (ptrdiff_t)dd * NPROJ); }
#pragma unroll
                for (int d = 1; d <= 16; ++d) { const float mk = d <= win ? 1.f : 0.f; const f32x2 mk2 = {mk, mk};
#pragma unroll
                    for (int q = 0; q < 4; ++q) sum[q] += (f32x2){bflo(hb[d - 1][q]), bfhi(hb[d - 1][q])} * mk2; }
            }
#define PL_BATCH(uc, qc, un, qn, tt0_) { { const int tn_ = (tt0_) + 8 < 32 ? (tt0_) + 8 : (tt0_); PL_LOAD(un, qn, tn_); } \
            _Pragma("unroll") for (int k = 0; k < 8; ++k) { const int tt = (tt0_) + k, sq = s0 + tt; const v4u u = uc[k], qv = qc[k]; \
                const float mk = (sq - win >= 0) ? 1.f : 0.f; const float inv = __builtin_amdgcn_rcpf((float)((sq + 1) < win ? (sq + 1) : win)); const f32x2 mk2 = {mk, mk}, inv2 = {inv, inv}; v4u o; \
                _Pragma("unroll") for (int q = 0; q < 4; ++q) { const f32x2 xc = {bflo(u[q]), bfhi(u[q])}, xo = {bflo(qv[q]), bfhi(qv[q])}; \
                    sum[q] += xc - xo * mk2; const f32x2 y = sum[q] * inv2 - xc; o[q] = pk2(y.x, y.y); } \
                *(v4u*)(OCATP + (size_t)(t0 + tt) * KCAT + c0) = o; } }
            PL_BATCH(ua, qa, ub, qb, 0); PL_BATCH(ub, qb, ua, qa, 8); PL_BATCH(ua, qa, ub, qb, 16); PL_BATCH(ub, qb, ua, qa, 24);
#undef PL_BATCH
#undef PL_LOAD
    }
}

typedef short s16x4 __attribute__((ext_vector_type(4)));
#define MFMA32(a, b, c) __builtin_amdgcn_mfma_f32_32x32x16_bf16((a), (b), (c), 0, 0, 0)
__device__ __forceinline__ bf16x8 ldfrag(const LAS bf16* p) { return *(const LAS bf16x8*)p; }
__device__ __forceinline__ bf16x8 trfrag(const LAS bf16* p0, const LAS bf16* p1) {
    const s16x4 lo = __builtin_amdgcn_ds_read_tr16_b64_v4i16((LAS s16x4*)p0), hi = __builtin_amdgcn_ds_read_tr16_b64_v4i16((LAS s16x4*)p1);
    return __builtin_shufflevector(lo, hi, 0, 1, 2, 3, 4, 5, 6, 7);
}
constexpr int D2_KN = 0, D2_QN = 17408, D2_VN = 34816, D2_KD = 52224, D2_TM = 69632, D2_QKM = 78848, D2_SC = 88064  , D2_PRIV = 91136, D2_PW = 8960;
static_assert(D2_PRIV + 8 * D2_PW <= MISC_OFF, "delta LDS map");
__device__ __forceinline__ void p3_delta(Frame& F, const Args& a) {
    const bf16* CONV = (const bf16*)(F.ws + WS_CONV); const bf16* PROJ = (const bf16*)(F.ws + WS_PROJ); const float* AB = (const float*)(F.ws + WS_AB);
    bf16* OCAT = (bf16*)(F.ws + WS_OCAT);
    bf16* Tg = (bf16*)(F.ws + WS_DT); bf16* QKg = (bf16*)(F.ws + WS_DQK); float* SCg = (float*)(F.ws + WS_DSC);
    const int tid = F.tid, lane = F.lane, w = F.wave, r = lane & 31, hh = lane >> 5;
    for (int unit = F.vcu; unit < 256; unit += F.G) {
        const int b = unit >> 5, h = unit & 31, qh = h >> 1;
        const float Aexp = __expf(a.in[I_ALOG][h]), dtb = a.in[I_DTB][h];
        const bf16* Qg = CONV + (size_t)(b * 16 + qh) * SEQ * 128; const bf16* Kg = Qg + CONV_K; const bf16* Vg = CONV + CONV_V + (size_t)(b * 32 + h) * SEQ * 128;
        __syncthreads();
        {
            LAS float* Lw = (LAS float*)(F.lds + w * 17920);
            LAS bf16* Sw = (LAS bf16*)(F.lds + w * 17920);
            LAS float* gtab = (LAS float*)(F.lds + w * 17920 + 17408);
            LAS float* btab = gtab + 64;
            float av_n = AB[(size_t)(b * SEQ + w * 64 + lane) * 256 + h], bv_n = AB[(size_t)(b * SEQ + w * 64 + lane) * 256 + 32 + h];
            for (int n = w; n < 32; n += 8) {
                int r = lane & 31, hh = lane >> 5; asm volatile("" : "+v"(r), "+v"(hh));
                const int t0 = b * SEQ + n * 64; const size_t cidx = (size_t)unit * 32 + n;
                bf16x8 kf[2][8], qfa[2][8];
#pragma unroll
                for (int bi = 0; bi < 2; ++bi)
#pragma unroll
                    for (int ks = 0; ks < 8; ++ks) { kf[bi][ks] = *(const bf16x8*)(Kg + (size_t)(n * 64 + 32 * bi + r) * 128 + 16 * ks + 8 * hh); qfa[bi][ks] = *(const bf16x8*)(Qg + (size_t)(n * 64 + 32 * bi + r) * 128 + 16 * ks + 8 * hh); }
                const float av = av_n, bv = bv_n;
                { const int nn = n + 8 < 32 ? n + 8 : n; av_n = AB[(size_t)(b * SEQ + nn * 64 + lane) * 256 + h]; bv_n = AB[(size_t)(b * SEQ + nn * 64 + lane) * 256 + 32 + h]; }
                const float xx = av + dtb, sp = xx > 20.f ? xx : log1pf(__expf(xx));
                const float gl = -Aexp * sp, be = sigmoidf_(bv);
                float gc = gl;
#pragma unroll
                for (int o = 1; o < 64; o <<= 1) { const float y = __shfl_up(gc, o); if (lane >= o) gc += y; }
                const float gc63 = __shfl(gc, 63);
                gtab[lane] = gc; btab[lane] = be; LDS_WAIT();
                SCg[(cidx * 3 + 0) * 64 + lane] = __expf(gc); SCg[(cidx * 3 + 1) * 64 + lane] = be; SCg[(cidx * 3 + 2) * 64 + lane] = __expf(gc63 - gc);
                const float gcol0 = __shfl(gc, r), gcol1 = __shfl(gc, 32 + r);
#pragma unroll
                for (int bi = 0; bi < 2; ++bi) {
                    bf16x8 qf[8];
#pragma unroll
                    for (int ks = 0; ks < 8; ++ks) qf[ks] = qfa[bi][ks];
#pragma unroll
                    for (int bm = 0; bm < 2; ++bm) {
                        f32x16 acc;
#pragma unroll
                        for (int i = 0; i < 16; ++i) acc[i] = 0.f;
                        if (bm <= bi) {
#pragma unroll
                            for (int ks = 0; ks < 8; ++ks) acc = MFMA32(qf[ks], kf[bm][ks], acc);
                        }
                        const float gm = bm ? gcol1 : gcol0; const int m = 32 * bm + r;
#pragma unroll
                        for (int g = 0; g < 4; ++g) { const f32x4 gi = *(const LAS f32x4*)(gtab + 32 * bi + 8 * g + 4 * hh);
#pragma unroll
                            for (int jj = 0; jj < 4; ++jj) { const int i = 32 * bi + 8 * g + 4 * hh + jj;
                                const float v = (i >= m) ? acc[4 * g + jj] * __expf(fminf(gi[jj] - gm, 0.f)) : 0.f;
                                Sw[i * 64 + m] = (bf16)f2bf(v); } }
                    }
                }
                LDS_WAIT();
#pragma unroll
                for (int x = 0; x < 8; ++x) { const int p = lane + 64 * x; *(v4u*)(QKg + cidx * 4096 + p * 8) = *(const LAS v4u*)(Sw + p * 8); }
                LDS_WAIT();
#pragma unroll
                for (int bi = 0; bi < 2; ++bi)
#pragma unroll
                    for (int bj = 0; bj <= bi; ++bj) {
                        f32x16 acc;
#pragma unroll
                        for (int i = 0; i < 16; ++i) acc[i] = 0.f;
#pragma unroll
                        for (int ks = 0; ks < 8; ++ks) acc = MFMA32(kf[bi][ks], kf[bj][ks], acc);
                        const float gj = bj ? gcol1 : gcol0;
#pragma unroll
                        for (int g = 0; g < 4; ++g) { const f32x4 gi = *(const LAS f32x4*)(gtab + 32 * bi + 8 * g + 4 * hh), bi4 = *(const LAS f32x4*)(btab + 32 * bi + 8 * g + 4 * hh);
#pragma unroll
                            for (int jj = 0; jj < 4; ++jj) { const int i = 32 * bi + 8 * g + 4 * hh + jj;
                                Lw[i * 68 + 32 * bj + r] = acc[4 * g + jj] * bi4[jj] * __expf(fminf(gi[jj] - gj, 0.f)); } }
                    }
                LDS_WAIT();
                f32x2 Tc2[32];
                int lv = lane; asm volatile("" : "+v"(lv));
                f32x4 rowA[16], rowB[16];
#define D1_LOADROW(dst, i_) do { _Pragma("unroll") for (int j4 = 0; j4 < ((i_) + 3) / 4; ++j4) dst[j4] = *(const LAS f32x4*)(Lw + (i_) * 68 + 4 * j4); } while (0)
#define D1_ROW(src, i_) do { f32x2 sA = (f32x2){((i_) == lv) ? 1.f : 0.f, 0.f}, sB = (f32x2){0.f, 0.f}, sC = (f32x2){0.f, 0.f}, sD = (f32x2){0.f, 0.f}; \
                    _Pragma("unroll") for (int j4 = 0; j4 < ((i_) + 3) / 4; ++j4) { if (j4 & 1) { sC -= (f32x2){src[j4][0], src[j4][1]} * Tc2[2 * j4]; sD -= (f32x2){src[j4][2], src[j4][3]} * Tc2[2 * j4 + 1]; } \
                                                                                       else { sA -= (f32x2){src[j4][0], src[j4][1]} * Tc2[2 * j4]; sB -= (f32x2){src[j4][2], src[j4][3]} * Tc2[2 * j4 + 1]; } } \
                    const f32x2 sS = (sA + sC) + (sB + sD); const float tv_ = sS.x + sS.y; if ((i_) & 1) Tc2[(i_) >> 1].y = tv_; else Tc2[(i_) >> 1].x = tv_; } while (0)
                constexpr int D1_PF = 44;
#define D1_ZERO(i_) do { if (((i_) & 3) == 0) { Tc2[(i_) >> 1] = (f32x2){0.f, 0.f}; Tc2[((i_) >> 1) + 1] = (f32x2){0.f, 0.f}; } } while (0)
                D1_LOADROW(rowA, 0);
#pragma unroll
                for (int ip = 0; ip < D1_PF / 2; ++ip) { const int i = 2 * ip;
                    D1_ZERO(i);     D1_LOADROW(rowB, i + 1); pg8::wait_l_n((i + 4) / 4); D1_ROW(rowA, i);     asm volatile("" ::: "memory");
                    D1_ZERO(i + 1); D1_LOADROW(rowA, i + 2); pg8::wait_l_n((i + 5) / 4); D1_ROW(rowB, i + 1); asm volatile("" ::: "memory");
                }
                D1_ZERO(D1_PF); asm volatile("s_waitcnt lgkmcnt(0)" ::: "memory"); D1_ROW(rowA, D1_PF); asm volatile("" ::: "memory");
#pragma unroll
                for (int i = D1_PF + 1; i < 64; ++i) {
                    D1_ZERO(i); D1_LOADROW(rowA, i); asm volatile("s_waitcnt lgkmcnt(0)" ::: "memory");
                    D1_ROW(rowA, i); asm volatile("" ::: "memory");
                }
#undef D1_ZERO
#undef D1_LOADROW
#undef D1_ROW
                LDS_WAIT();
#pragma unroll
                for (int i = 0; i < 64; ++i) Sw[i * 64 + lane] = (bf16)f2bf((i & 1) ? Tc2[i >> 1].y : Tc2[i >> 1].x);
                LDS_WAIT();
#pragma unroll
                for (int x = 0; x < 8; ++x) { const int p = lane + 64 * x; *(v4u*)(Tg + cidx * 4096 + p * 8) = *(const LAS v4u*)(Sw + p * 8); }
                LDS_WAIT();
            }
        }
    }
    VM_WAIT();
    __syncthreads();
    for (int unit = F.vcu; unit < 256; unit += F.G) {
        const int b = unit >> 5, h = unit & 31, qh = h >> 1;
        const bf16* Qg = CONV + (size_t)(b * 16 + qh) * SEQ * 128; const bf16* Kg = Qg + CONV_K; const bf16* Vg = CONV + CONV_V + (size_t)(b * 32 + h) * SEQ * 128;
        __syncthreads();
        LAS bf16* Kn = (LAS bf16*)(F.lds + D2_KN); LAS bf16* Qn = (LAS bf16*)(F.lds + D2_QN); LAS bf16* Vn = (LAS bf16*)(F.lds + D2_VN); LAS bf16* Kd = (LAS bf16*)(F.lds + D2_KD);
        LAS bf16* Tm = (LAS bf16*)(F.lds + D2_TM); LAS bf16* QKm = (LAS bf16*)(F.lds + D2_QKM);
        LAS float* sa = (LAS float*)(F.lds + D2_SC); LAS float* sb = sa + 64; LAS float* ssp = sb + 64; LAS float* owl = ssp + 512;
        LAS bf16* STw = (LAS bf16*)(F.lds + D2_PRIV + w * D2_PW); LAS bf16* RTw = STw + 16 * 136; LAS bf16* VnTw = RTw + 16 * 72;
        LAS bf16* SQw = RTw;
        const int c = lane & 15, q = lane >> 4, E0 = 16 * w;
        for (int i = lane; i < 16 * 136 / 8; i += 64) *(LAS v4u*)(STw + i * 8) = (v4u){0u, 0u, 0u, 0u};
        f32x4 sacc[8];
#pragma unroll
        for (int x = 0; x < 8; ++x) sacc[x] = (f32x4){0.f, 0.f, 0.f, 0.f};
        v4u pK[2], pQ[2], pV[2], pT, pQK; float psc[2], psa = 0.f, psb = 0.f; v4u pz[2];
        const int prow = tid >> 4, pcol = (tid & 15) * 8;
        if (tid < 128) owl[tid] = a.in[I_ONW][tid];
        f32x2 oww[8];
#pragma unroll
        for (int x = 0; x < 8; ++x) oww[x] = *(const f32x2*)(a.in[I_ONW] + E0 + 2 * x);
#define D2_PREFETCH(n_) do { const int t0_ = b * SEQ + (n_) * 64; const size_t ci_ = (size_t)unit * 32 + (n_); \
            _Pragma("unroll") for (int x = 0; x < 2; ++x) { const size_t ro_ = (size_t)((n_) * 64 + prow + 32 * x) * 128 + pcol; pK[x] = *(const v4u*)(Kg + ro_); pQ[x] = *(const v4u*)(Qg + ro_); pV[x] = *(const v4u*)(Vg + ro_); \
                psc[x] = SCg[(ci_ * 3 + 2) * 64 + prow + 32 * x]; } \
            pT = *(const v4u*)(Tg + ci_ * 4096 + tid * 8); pQK = *(const v4u*)(QKg + ci_ * 4096 + tid * 8); \
            if (tid < 64) { psa = SCg[(ci_ * 3 + 0) * 64 + tid]; psb = SCg[(ci_ * 3 + 1) * 64 + tid]; } } while (0)
#define D2_ZPREFETCH(n_) do { const bf16* zp_ = PROJ + (size_t)(b * SEQ + (n_) * 64 + lane) * NPROJ + PC_Z + h * 128 + E0; pz[0] = *(const v4u*)zp_; pz[1] = *(const v4u*)(zp_ + 8); } while (0)
#define MFMA16(a_, b_, c_) __builtin_amdgcn_mfma_f32_16x16x32_bf16((a_), (b_), (c_), 0, 0, 0)
        D2_PREFETCH(0);
        asm volatile("" : "+v"(pK[0]), "+v"(pK[1]), "+v"(pQ[0]), "+v"(pQ[1]), "+v"(pV[0]), "+v"(pV[1]), "+v"(pT), "+v"(pQK));
        asm volatile("" : "+v"(psc[0]), "+v"(psc[1]), "+v"(psa), "+v"(psb));
        D2_ZPREFETCH(0);
        for (int n = 0; n < 32; ++n) {
            const int t0 = b * SEQ + n * 64;
            asm volatile("" : "+v"(pK[0]), "+v"(pK[1]), "+v"(pQ[0]), "+v"(pQ[1]), "+v"(pV[0]), "+v"(pV[1]), "+v"(pT), "+v"(pQK));
            asm volatile("" : "+v"(psc[0]), "+v"(psc[1]), "+v"(psa), "+v"(psb));
#pragma unroll
            for (int x = 0; x < 2; ++x) { const int row = prow + 32 * x;
                *(LAS v4u*)(Kn + row * 136 + pcol) = pK[x]; *(LAS v4u*)(Qn + row * 136 + pcol) = pQ[x]; *(LAS v4u*)(Vn + row * 136 + pcol) = pV[x];
                const float cs = psc[x]; v4u kd;
                kd.x = pk2(bflo(pK[x].x) * cs, bfhi(pK[x].x) * cs); kd.y = pk2(bflo(pK[x].y) * cs, bfhi(pK[x].y) * cs); kd.z = pk2(bflo(pK[x].z) * cs, bfhi(pK[x].z) * cs); kd.w = pk2(bflo(pK[x].w) * cs, bfhi(pK[x].w) * cs);
                *(LAS v4u*)(Kd + row * 136 + pcol) = kd; }
            *(LAS v4u*)(Tm + (tid >> 3) * 72 + (tid & 7) * 8) = pT; *(LAS v4u*)(QKm + (tid >> 3) * 72 + (tid & 7) * 8) = pQK;
            if (tid < 64) { sa[tid] = psa; sb[tid] = psb; }
            LDS_WAIT(); __builtin_amdgcn_s_barrier(); asm volatile("" ::: "memory");
            const float dc = sa[63];
            { const int nn = n + 1 < 32 ? n + 1 : 31; D2_PREFETCH(nn); }
            f32x4 aks[4], aqs[4]; f32x2 gz[8];
#pragma unroll
            for (int rb = 0; rb < 4; ++rb) { aks[rb] = (f32x4){0.f, 0.f, 0.f, 0.f}; aqs[rb] = (f32x4){0.f, 0.f, 0.f, 0.f}; }
#pragma unroll
            for (int kh = 0; kh < 2; ++kh) {
                bf16x8 bfr[2], kfr[2][4], qfr[2][4];
#pragma unroll
                for (int k2 = 0; k2 < 2; ++k2) { const int ks = 2 * kh + k2; bfr[k2] = ldfrag(STw + c * 136 + 32 * ks + 8 * q);
#pragma unroll
                    for (int rb = 0; rb < 4; ++rb) { kfr[k2][rb] = ldfrag(Kn + (16 * rb + c) * 136 + 32 * ks + 8 * q); qfr[k2][rb] = ldfrag(Qn + (16 * rb + c) * 136 + 32 * ks + 8 * q); } }
                __builtin_amdgcn_sched_barrier(0);
                if (kh == 0) {
                    asm volatile("" : "+v"(pz[0]), "+v"(pz[1]));
#pragma unroll
                    for (int x = 0; x < 8; ++x) { const unsigned zu = x < 4 ? pz[0][x] : pz[1][x - 4]; const float z0 = bflo(zu), z1 = bfhi(zu);
                        gz[x] = (f32x2){oww[x].x * (z0 * sigmoidf_(z0)), oww[x].y * (z1 * sigmoidf_(z1))}; }
                    __builtin_amdgcn_sched_barrier(0);
                }
#pragma unroll
                for (int k2 = 0; k2 < 2; ++k2)
#pragma unroll
                    for (int rb = 0; rb < 4; ++rb) { aks[rb] = MFMA16(kfr[k2][rb], bfr[k2], aks[rb]); aqs[rb] = MFMA16(qfr[k2][rb], bfr[k2], aqs[rb]); }
                __builtin_amdgcn_sched_barrier(0);
            }
            { f32x4 a4[4], b4[4]; unsigned short vv[16];
#pragma unroll
              for (int rb = 0; rb < 4; ++rb) { const int i0 = 16 * rb + 4 * q; a4[rb] = *(const LAS f32x4*)(sa + i0); b4[rb] = *(const LAS f32x4*)(sb + i0);
#pragma unroll
                for (int j = 0; j < 4; ++j) vv[4 * rb + j] = Vn[(i0 + j) * 136 + E0 + c]; }
              __builtin_amdgcn_sched_barrier(0);
#pragma unroll
              for (int rb = 0; rb < 4; ++rb) { const int i0 = 16 * rb + 4 * q; float rv[4];
#pragma unroll
                for (int j = 0; j < 4; ++j) { rv[j] = b4[rb][j] * (bflo((unsigned)vv[4 * rb + j]) - a4[rb][j] * aks[rb][j]); aqs[rb][j] *= a4[rb][j]; }
                v2u pk; pk.x = pk2(rv[0], rv[1]); pk.y = pk2(rv[2], rv[3]); *(LAS v2u*)(RTw + c * 72 + i0) = pk; } }
            LDS_WAIT();
            { bf16x8 tfr[4][2], rfr[2]; f32x4 va[4];
#pragma unroll
              for (int ks = 0; ks < 2; ++ks) { rfr[ks] = ldfrag(RTw + c * 72 + 32 * ks + 8 * q);
#pragma unroll
                for (int rb = 0; rb < 4; ++rb) if (ks == 0 || rb >= 2) tfr[rb][ks] = ldfrag(Tm + (16 * rb + c) * 72 + 32 * ks + 8 * q); }
              __builtin_amdgcn_sched_barrier(0);
#pragma unroll
              for (int rb = 0; rb < 4; ++rb) { va[rb] = (f32x4){0.f, 0.f, 0.f, 0.f};
#pragma unroll
                for (int ks = 0; ks < 2; ++ks) if (ks == 0 || rb >= 2) va[rb] = MFMA16(tfr[rb][ks], rfr[ks], va[rb]); }
#pragma unroll
              for (int rb = 0; rb < 4; ++rb) { v2u pk; pk.x = pk2(va[rb][0], va[rb][1]); pk.y = pk2(va[rb][2], va[rb][3]); *(LAS v2u*)(VnTw + c * 72 + 16 * rb + 4 * q) = pk; } }
            LDS_WAIT();
            bf16x8 vfr[2];
            { bf16x8 qkf[4][2];
#pragma unroll
              for (int ks = 0; ks < 2; ++ks) { vfr[ks] = ldfrag(VnTw + c * 72 + 32 * ks + 8 * q);
#pragma unroll
                for (int rb = 0; rb < 4; ++rb) if (ks == 0 || rb >= 2) qkf[rb][ks] = ldfrag(QKm + (16 * rb + c) * 72 + 32 * ks + 8 * q); }
              __builtin_amdgcn_sched_barrier(0);
#pragma unroll
              for (int rb = 0; rb < 4; ++rb) {
#pragma unroll
                for (int ks = 0; ks < 2; ++ks) if (ks == 0 || rb >= 2) aqs[rb] = MFMA16(qkf[rb][ks], vfr[ks], aqs[rb]); }
#pragma unroll
              for (int rb = 0; rb < 4; ++rb)
#pragma unroll
                for (int j = 0; j < 4; ++j) SQw[(16 * rb + 4 * q + j) * 18 + c] = (bf16)f2bf(aqs[rb][j]); }
            LDS_WAIT();
            unsigned orow[8];
            { float ssum = 0.f;
#pragma unroll
              for (int x = 0; x < 8; ++x) { orow[x] = *(const LAS unsigned*)(SQw + lane * 18 + 2 * x); ssum += bflo(orow[x]) * bflo(orow[x]) + bfhi(orow[x]) * bfhi(orow[x]); }
              ssp[w * 64 + lane] = ssum; }
            { const int tq = (lane & 15) >> 2, tp = lane & 3;
#pragma unroll
              for (int dh = 0; dh < 2; ++dh) { bf16x8 kfrT[4][2];
#pragma unroll
                for (int d4 = 0; d4 < 4; ++d4)
#pragma unroll
                  for (int ks = 0; ks < 2; ++ks) { const LAS bf16* kp = Kd + (32 * ks + 8 * q + tq) * 136 + 16 * (4 * dh + d4) + 4 * tp; kfrT[d4][ks] = trfrag(kp, kp + 4 * 136); }
                __builtin_amdgcn_sched_barrier(0);
#pragma unroll
                for (int d4 = 0; d4 < 4; ++d4) { const int db = 4 * dh + d4; sacc[db] *= dc;
#pragma unroll
                  for (int ks = 0; ks < 2; ++ks) sacc[db] = MFMA16(kfrT[d4][ks], vfr[ks], sacc[db]); }
#pragma unroll
                for (int d4 = 0; d4 < 4; ++d4) { const int db = 4 * dh + d4; v2u pk; pk.x = pk2(sacc[db][0], sacc[db][1]); pk.y = pk2(sacc[db][2], sacc[db][3]); *(LAS v2u*)(STw + c * 136 + 16 * db + 4 * q) = pk; }
                __builtin_amdgcn_sched_barrier(0); } }
            LDS_WAIT(); __builtin_amdgcn_s_barrier(); asm volatile("" ::: "memory");
            asm volatile("" : "+v"(pK[0]), "+v"(pK[1]), "+v"(pQ[0]), "+v"(pQ[1]), "+v"(pV[0]), "+v"(pV[1]), "+v"(pT), "+v"(pQK));
            asm volatile("" : "+v"(psc[0]), "+v"(psc[1]), "+v"(psa), "+v"(psb));
            { float tt = 0.f;
#pragma unroll
              for (int ww = 0; ww < 8; ++ww) tt += ssp[ww * 64 + lane];
              const float rstd = __frsqrt_rn(tt * (1.f / 128.f) + RMS_EPS);
              unsigned ov[8];
#pragma unroll
              for (int x = 0; x < 8; ++x) ov[x] = pk2(bflo(orow[x]) * rstd * gz[x].x, bfhi(orow[x]) * rstd * gz[x].y);
              bf16* op = OCAT + (size_t)(t0 + lane) * KCAT + h * 128 + E0;
              *(v4u*)op = (v4u){ov[0], ov[1], ov[2], ov[3]}; *(v4u*)(op + 8) = (v4u){ov[4], ov[5], ov[6], ov[7]}; }
            { const int nn = n + 1 < 32 ? n + 1 : 31; D2_ZPREFETCH(nn); }
        }
        __syncthreads();
#undef MFMA16
#undef D2_ZPREFETCH
#undef D2_PREFETCH
    }
}

__device__ __forceinline__ void p6_router(Frame& F, const Args& a) {
    const bf16* X1 = (const bf16*)(F.ws + WS_X1); const float* RWT = (const float*)(F.ws + WS_ROUTE + RT_RWT); const float* RB = a.in[I_RB];
    int* tok_e = (int*)(F.ws + WS_ROUTE + RT_E); int* tok_slot = (int*)(F.ws + WS_ROUTE + RT_SLOT); float* tok_gate = (float*)(F.ws + WS_ROUTE + RT_GATE); float* rstdp = (float*)(F.ws + WS_ROUTE + RT_RSTD);
    LAS float* part = (LAS float*)(F.lds);
    LAS float* ssq = (LAS float*)(F.lds + 8 * 32 * 33 * 4);
    LAS float* lg = ssq + 256;
    LAS float* sst = lg + 32 * 33;
    const int lane = F.lane, w = F.wave, r = lane & 31, hh = lane >> 5;
    unsigned char* XQ = (unsigned char*)(F.ws + WS_XBUF); int* tokmap = (int*)(F.ws + WS_TOKMAP); const float* N2 = a.in[I_N2W];
    f32x4 wv2[8];
#pragma unroll
    for (int j = 0; j < 8; ++j) wv2[j] = *(const f32x4*)(N2 + 4 * lane + 256 * j);
    bf16x8 wh[16], wl[16];
    { const bf16* whr = (const bf16*)RWT + (size_t)r * D + 256 * w + 8 * hh; const bf16* wlr = whr + (size_t)NE * D;
#pragma unroll
      for (int j = 0; j < 16; ++j) { wh[j] = *(const bf16x8*)(whr + 16 * j); wl[j] = *(const bf16x8*)(wlr + 16 * j); } }
    for (int tile = F.vcu; tile < T / 32; tile += F.G) {
        const int t0 = tile * 32;
        f32x16 acc;
#pragma unroll
        for (int i = 0; i < 16; ++i) acc[i] = 0.f;
        float ss = 0.f;
        const bf16* xrow = X1 + (size_t)(t0 + r) * D + 256 * w + 8 * hh;
#pragma unroll
        for (int sb = 0; sb < 16; sb += 8) {
            bf16x8 xa[8];
#pragma unroll
            for (int j = 0; j < 8; ++j) xa[j] = *(const bf16x8*)(xrow + 16 * (sb + j));
#pragma unroll
            for (int j = 0; j < 8; ++j) { const v4u xu = __builtin_bit_cast(v4u, xa[j]);
#pragma unroll
                for (int q = 0; q < 4; ++q) { const float x0 = bflo(xu[q]), x1v = bfhi(xu[q]); ss += x0 * x0 + x1v * x1v; }
                acc = MFMA32(xa[j], wh[sb + j], acc); acc = MFMA32(xa[j], wl[sb + j], acc); }
        }
        ss += __shfl_xor(ss, 32);
        __syncthreads();
#pragma unroll
        for (int g = 0; g < 4; ++g)
#pragma unroll
            for (int jj = 0; jj < 4; ++jj) part[(w * 32 + 8 * g + 4 * hh + jj) * 33 + r] = acc[4 * g + jj];
        if (hh == 0) ssq[w * 32 + r] = ss;
        __syncthreads();
        for (int idx = F.tid; idx < 1024; idx += 512) { const int tk = idx >> 5, ee = idx & 31; float s = 0.f;
#pragma unroll
            for (int ww = 0; ww < 8; ++ww) s += part[(ww * 32 + tk) * 33 + ee];
            lg[tk * 33 + ee] = s; }
        if (F.tid < 32) { float s = 0.f;
#pragma unroll
            for (int ww = 0; ww < 8; ++ww) s += ssq[ww * 32 + F.tid];
            sst[F.tid] = s; }
        __syncthreads();
        if (w == 0) {
            const int tk = lane & 31; const bool valid = lane < 32;
            const float rstd = __frsqrt_rn(sst[tk] * (1.f / D) + RMS_EPS);
            float v[32];
#pragma unroll
            for (int ee = 0; ee < 32; ++ee) v[ee] = lg[tk * 33 + ee] * rstd + RB[ee];
            unsigned taken = 0u; float tv[4]; int te[4];
#pragma unroll
            for (int k = 0; k < 4; ++k) { float best = -3.0e38f; int bi = 0;
#pragma unroll
                for (int ee = 0; ee < 32; ++ee) { const bool ok = !((taken >> ee) & 1u) && (v[ee] > best); best = ok ? v[ee] : best; bi = ok ? ee : bi; }
                tv[k] = best; te[k] = bi; taken |= 1u << bi; }
            const float e1 = __expf(tv[1] - tv[0]), e2 = __expf(tv[2] - tv[0]), e3 = __expf(tv[3] - tv[0]);
            const float inv = 1.0f / (1.0f + e1 + e2 + e3);
            const float gt[4] = {inv, e1 * inv, e2 * inv, e3 * inv};
            unsigned mycnt = 0u; int rk[4] = {0, 0, 0, 0};
            const unsigned long long ltmask = (1ull << lane) - 1ull;
#pragma unroll
            for (int ee = 0; ee < 32; ++ee) {
                const bool has = valid && ((taken >> ee) & 1u);
                const unsigned long long bal = __ballot(has);
                const unsigned c = (unsigned)__popcll(bal), rnk = (unsigned)__popcll(bal & ltmask);
                mycnt = (lane == ee) ? c : mycnt;
#pragma unroll
                for (int k = 0; k < 4; ++k) rk[k] = (te[k] == ee) ? (int)rnk : rk[k];
            }
            unsigned base = 0u;
            if (valid && mycnt > 0u) base = atomicAdd(F.ctl + CW_CNT + 64 * lane, mycnt);
#pragma unroll
            for (int k = 0; k < 4; ++k) { const int bs = __shfl((int)base, te[k]); rk[k] += bs; }
            if (valid) {
                *(int4*)(tok_e + (size_t)(t0 + tk) * 4) = make_int4(te[0], te[1], te[2], te[3]);
                *(int4*)(tok_slot + (size_t)(t0 + tk) * 4) = make_int4(rk[0], rk[1], rk[2], rk[3]);
                *(float4*)(tok_gate + (size_t)(t0 + tk) * 4) = make_float4(gt[0], gt[1], gt[2], gt[3]);
                rstdp[t0 + tk] = rstd;
#pragma unroll
                for (int k = 0; k < 4; ++k) tokmap[(size_t)te[k] * T + rk[k]] = t0 + tk;
            }
        } else {
            for (int tk = w - 1; tk < 32; tk += 7) {
                const float rstd = __frsqrt_rn(sst[tk] * (1.f / D) + RMS_EPS) * F8_SX; const int m = t0 + tk;
                const v2u* xp = (const v2u*)(X1 + (size_t)m * D) + lane; unsigned* o0 = (unsigned*)(XQ + (size_t)m * D) + lane; v2u xv[8];
#pragma unroll
                for (int j = 0; j < 8; ++j) xv[j] = xp[64 * j];
#pragma unroll
                for (int j = 0; j < 8; ++j) { const f32x4 y = (f32x4){bflo(xv[j].x), bfhi(xv[j].x), bflo(xv[j].y), bfhi(xv[j].y)} * rstd * wv2[j]; o0[64 * j] = pk4_f8(y.x, y.y, y.z, y.w); }
            }
        }
    }
}

__device__ __forceinline__ int moe_tables(Frame& F, LAS int* tile_e, LAS int* tbase, LAS int* rowoff) {
    __syncthreads();
    if (F.wave == 0) {
        const int ee = F.lane & 31;
        const unsigned cnt = __hip_atomic_load(F.ctl + CW_CNT + 64 * ee, __ATOMIC_RELAXED, __HIP_MEMORY_SCOPE_AGENT);
        const int nt = (int)((cnt + 255u) >> 8);
        int incl = nt;
#pragma unroll
        for (int o = 1; o < 32; o <<= 1) { const int y = __shfl_up(incl, o, 32); if ((F.lane & 31) >= o) incl += y; }
        const int excl = incl - nt;
        if (F.lane < 32) { rowoff[ee] = excl * 256; for (int i = 0; i < nt; ++i) { tile_e[excl + i] = ee; tbase[excl + i] = ee * T + i * 256; } if (ee == 31) rowoff[32] = incl; }
    }
    __syncthreads();
    return rowoff[32];
}

__device__ __forceinline__ float wave_sum_x(float v) {
    v += dppf<0xB1>(v); v += dppf<0x4E>(v); v += dppf<0x141>(v); v += dppf<0x140>(v);
    { const unsigned u = __builtin_bit_cast(unsigned, v); const auto r = __builtin_amdgcn_permlane16_swap(u, u, false, false); const unsigned r0 = r[0], r1 = r[1]; v = __builtin_bit_cast(float, r0) + __builtin_bit_cast(float, r1); }
    { const unsigned u = __builtin_bit_cast(unsigned, v); const auto r = __builtin_amdgcn_permlane32_swap(u, u, false, false); const unsigned r0 = r[0], r1 = r[1]; v = __builtin_bit_cast(float, r0) + __builtin_bit_cast(float, r1); }
    return v;
}
__device__ __forceinline__ void p10_final(Frame& F, const Args& a) {
    const bf16* X1 = (const bf16*)(F.ws + WS_X1); const unsigned char* Y = (const unsigned char*)(F.ws + WS_Y); const float* NF = a.in[I_NFW];
    const int* tok_e = (const int*)(F.ws + WS_ROUTE + RT_E); const int* tok_slot = (const int*)(F.ws + WS_ROUTE + RT_SLOT); const float* tok_gate = (const float*)(F.ws + WS_ROUTE + RT_GATE);
    LAS int* rowoff = (LAS int*)(F.lds + pg8::STAGE_BYTES + 6656);
    (void)moe_tables(F, (LAS int*)(F.lds + pg8::STAGE_BYTES + 4096), (LAS int*)(F.lds + pg8::STAGE_BYTES + 5376), rowoff);
    const int gw = F.vcu * 8 + F.wave, NGW = F.G * 8, lane = F.lane;
    f32x4 wv[8];
#pragma unroll
    for (int j = 0; j < 8; ++j) wv[j] = *(const f32x4*)(NF + 4 * lane + 256 * j);
    for (int base = gw; base < T; base += 4 * NGW) {
        int4 te[4], sl[4]; float4 gg[4]; int4 rr[4];
#pragma unroll
        for (int k = 0; k < 4; ++k) { const int mc = base + k * NGW < T ? base + k * NGW : T - 1; te[k] = *(const int4*)(tok_e + (size_t)mc * 4); sl[k] = *(const int4*)(tok_slot + (size_t)mc * 4); gg[k] = *(const float4*)(tok_gate + (size_t)mc * 4); }
#pragma unroll
        for (int k = 0; k < 4; ++k) rr[k] = make_int4(rowoff[te[k].x] + sl[k].x, rowoff[te[k].y] + sl[k].y, rowoff[te[k].z] + sl[k].z, rowoff[te[k].w] + sl[k].w);
        v2u xb[2][8]; unsigned yb[2][4][8];
#define P10_LOAD(k_, b_) { const int mc_ = base + (k_) * NGW < T ? base + (k_) * NGW : T - 1; const v2u* xr_ = (const v2u*)(X1 + (size_t)mc_ * D) + lane; \
            const unsigned* y0_ = (const unsigned*)(Y + (size_t)rr[k_].x * D) + lane; const unsigned* y1_ = (const unsigned*)(Y + (size_t)rr[k_].y * D) + lane; \
            const unsigned* y2_ = (const unsigned*)(Y + (size_t)rr[k_].z * D) + lane; const unsigned* y3_ = (const unsigned*)(Y + (size_t)rr[k_].w * D) + lane; \
            _Pragma("unroll") for (int j = 0; j < 8; ++j) { xb[b_][j] = xr_[64 * j]; yb[b_][0][j] = y0_[64 * j]; yb[b_][1][j] = y1_[64 * j]; yb[b_][2][j] = y2_[64 * j]; yb[b_][3][j] = y3_[64 * j]; } }
        P10_LOAD(0, 0);
#pragma unroll
        for (int k = 0; k < 4; ++k) {
            const int cb = k & 1;
            if (k + 1 < 4) P10_LOAD(k + 1, cb ^ 1);
            const int m = base + k * NGW;
            const float g0 = gg[k].x * (1.f / F8_SY), g1 = gg[k].y * (1.f / F8_SY), g2 = gg[k].z * (1.f / F8_SY), g3 = gg[k].w * (1.f / F8_SY);
            f32x4 v[8]; float ssq = 0.f;
#pragma unroll
            for (int j = 0; j < 8; ++j) {
                const v2u xv = xb[cb][j]; f32x4 acc = (f32x4){bflo(xv.x), bfhi(xv.x), bflo(xv.y), bfhi(xv.y)};
                acc += f8x4(yb[cb][0][j]) * g0; acc += f8x4(yb[cb][1][j]) * g1; acc += f8x4(yb[cb][2][j]) * g2; acc += f8x4(yb[cb][3][j]) * g3;
                v[j] = acc; ssq += (acc.x * acc.x + acc.y * acc.y) + (acc.z * acc.z + acc.w * acc.w);
            }
            const float rstd = __frsqrt_rn(wave_sum_x(ssq) * (1.f / D) + RMS_EPS);
            if (m < T) { f32x4* o = (f32x4*)(a.out + (size_t)m * D) + lane;
#pragma unroll
                for (int j = 0; j < 8; ++j) o[64 * j] = v[j] * rstd * wv[j]; }
        }
#undef P10_LOAD
    }
}

constexpr int NPHASE = 11;
__global__ void __launch_bounds__(512, 2) fwd(Args args) {
    extern __shared__ __attribute__((aligned(16))) unsigned char lds[];
    Frame F;
    F.lds = (LAS unsigned char*)lds; F.ws = args.ws; F.ctl = (unsigned*)(args.ws + WS_CTL);
    F.tid = threadIdx.x; F.lane = F.tid & 63; F.wave = __builtin_amdgcn_readfirstlane(F.tid >> 6);
    F.G = gridDim.x; { const int bx = blockIdx.x; F.vcu = (F.G % 8 == 0) ? (bx % 8) * (F.G / 8) + bx / 8 : bx; }
    volatile LAS unsigned* MISC = (volatile LAS unsigned*)(F.lds + MISC_OFF);
    if (F.tid < 64) MISC[F.tid] = 0u;
    __syncthreads();
    const int lo = args.ph_lo, hi = args.ph_hi;
    XcdBarrier bar; bar.bar = F.ctl + CW_BAR; bar.x = 0; bar.st = nullptr;
    if (hi - lo > 1) bar = xcd_barrier_post(F.ctl + CW_BAR, MISC + 8);
#define IN(k) (lo <= (k) && (k) < hi)
#define SEAM(k) do { if (IN(k) && IN((k) + 1)) xcd_barrier(bar); } while (0)
    unsigned char* ws = args.ws;
    LAS int* tile_e = (LAS int*)(F.lds + pg8::STAGE_BYTES + 4096);
    LAS int* tbase = (LAS int*)(F.lds + pg8::STAGE_BYTES + 5376); LAS int* rowoff = (LAS int*)(F.lds + pg8::STAGE_BYTES + 6656);

    if (IN(0)) { p0_prologue(F, args); SEAM(0); }
    if (IN(1)) {
        pg8::EpiProj E{(bf16*)(ws + WS_PROJ), (float*)(ws + WS_AB)};
        if (F.G == 256) {
            const int xcd = (int)blockIdx.x & 7, j = (int)blockIdx.x >> 3;
            if (j >= 24) { p_convert_experts(F, args, ((j - 24) * 8 + xcd) * 8 + F.wave, 64 * 8); __syncthreads(); }
            pg8::SchedP1 S{xcd, j, (const char*)(ws + WS_XN), (const char*)(ws + WS_WIN), (size_t)256 * LDX * 2, (size_t)256 * LDX * 2};
            pg8::gemm_phase<pg8::EpiProj, pg8::SchedP1, true, true>(F.lds, LDX, LDX, S, E);
        } else {
            pg8::Sched<0> S; S.init(T / 256, NWIN_T / 256, F.G, (int)blockIdx.x, D / 64); S.A = (const char*)(ws + WS_XN); S.B = (const char*)(ws + WS_WIN); S.tA = (size_t)256 * LDX * 2; S.tB = (size_t)256 * LDX * 2; S.tile_e = nullptr; S.estride = 0;
            pg8::gemm_phase<pg8::EpiProj, pg8::Sched<0>, true, true>(F.lds, LDX, LDX, S, E);
        }
        SEAM(1);
    }
    if (IN(2)) { p2_prep(F, args); SEAM(2); }
    if (IN(3)) {
        p3_delta(F, args);
        __syncthreads();
        pg8::Sched<1> S; S.init(D / 256, D / 256, F.G, (int)blockIdx.x, 512 / 64); S.A = (const char*)(ws + WS_WCAT) + 8192; S.B = (const char*)(ws + WS_WPOOL); S.tA = (size_t)256 * KCAT * 2; S.tB = (size_t)256 * 512 * 2; S.tile_e = nullptr; S.estride = 0;
        pg8::EpiFold E{(bf16*)(ws + WS_MIXED)};
        pg8::gemm_phase<pg8::EpiFold, pg8::Sched<1>, true, true>(F.lds, KCAT, 512, S, E);
        SEAM(3);
    }
    if (IN(4)) {
        pg8::Sched<3> S; S.init(T / 256, D / 256, F.G, (int)blockIdx.x, 0); S.A = (const char*)(ws + WS_OCAT); S.B = (const char*)(ws + WS_WCAT); S.tA = (size_t)256 * KCAT * 2; S.tB = (size_t)256 * KCAT * 2; S.tile_e = nullptr; S.estride = 0; S.bdelta1 = WS_MIXED - WS_WCAT;
        pg8::EpiBranch E{(bf16*)(ws + WS_H), (const bf16*)(ws + WS_PROJ), args.in[I_BGATE]};
        pg8::gemm_phase<pg8::EpiBranch, pg8::Sched<3>, true, true>(F.lds, KCAT, KCAT, S, E);
        SEAM(4);
    }
    if (IN(5)) {
        pg8::Sched<0> S; S.init(T / 256, D / 256, F.G, (int)blockIdx.x, D / 64); S.A = (const char*)(ws + WS_H); S.B = (const char*)(ws + WS_WOUT); S.tA = (size_t)256 * D * 2; S.tB = (size_t)256 * D * 2; S.tile_e = nullptr; S.estride = 0;
        pg8::EpiOut E{args.in[I_X], (bf16*)(ws + WS_X1)};
        pg8::gemm_phase<pg8::EpiOut, pg8::Sched<0>, true, true>(F.lds, D, D, S, E);
        SEAM(5);
    }
    if (IN(6)) { p6_router(F, args); SEAM(6); }
    if (IN(8)) {
        const int ntiles = moe_tables(F, tile_e, tbase, rowoff);
        pg8::Sched<4> S; S.init(ntiles, (2 * DE) / 256, F.G, (int)blockIdx.x, D / 128); S.A = (const char*)(ws + WS_XBUF); S.B = (const char*)(ws + WS_W1); S.tA = (size_t)256 * D; S.tB = (size_t)256 * D; S.tile_e = tile_e; S.estride = (size_t)2 * DE * D;
        S.rowtok = (const int*)(ws + WS_TOKMAP); S.tbase = tbase; S.tokmax = (unsigned)(T - 1);
        pg8::EpiSwiglu E{(unsigned char*)(ws + WS_ACT), args.in[I_B1], tile_e};
        pg8::gemm_phase<pg8::EpiSwiglu, pg8::Sched<4>, true, true, true>(F.lds, D / 2, D / 2, S, E);
        SEAM(8);
    }
    if (IN(9)) {
        const int ntiles = moe_tables(F, tile_e, tbase, rowoff);
        pg8::Sched<2> S; S.init(ntiles, D / 256, F.G, (int)blockIdx.x, DE / 128); S.A = (const char*)(ws + WS_ACT); S.B = (const char*)(ws + WS_W2); S.tA = (size_t)256 * DE; S.tB = (size_t)256 * DE; S.tile_e = tile_e; S.estride = (size_t)D * DE;
        pg8::EpiY E{(unsigned char*)(ws + WS_Y), args.in[I_B2], tile_e};
        pg8::gemm_phase<pg8::EpiY, pg8::Sched<2>, true, true, true>(F.lds, DE / 2, DE / 2, S, E);
        SEAM(9);
    }
    if (IN(10)) { p10_final(F, args); }
#undef IN
#undef SEAM
}

extern "C" void kernel_launch(void* const* d_in, const int* in_sizes, int n_in, void* d_out, int out_size, void* d_ws, size_t ws_size, hipStream_t stream) {
    static int grid = 0;
    if (grid == 0) {
        if (n_in != 21 || out_size != T * D || ws_size < WS_END) { fprintf(stderr, "kernel_launch: unexpected shapes (n_in %d, out %d, ws %zu < %zu)\n", n_in, out_size, ws_size, (size_t)WS_END); grid = -1; return; }
        int dev = 0, cus = 0, per_cu = 0;
        if (hipGetDevice(&dev) != hipSuccess || hipDeviceGetAttribute(&cus, hipDeviceAttributeMultiprocessorCount, dev) != hipSuccess) { grid = -1; return; }
        if (hipFuncSetAttribute((const void*)fwd, hipFuncAttributeMaxDynamicSharedMemorySize, LDS_BYTES) != hipSuccess) { fprintf(stderr, "kernel_launch: hipFuncSetAttribute failed\n"); grid = -1; return; }
        if (hipOccupancyMaxActiveBlocksPerMultiprocessor(&per_cu, (const void*)fwd, 512, LDS_BYTES) != hipSuccess || per_cu < 1) fprintf(stderr, "kernel_launch: occupancy query reports %d\n", per_cu);
        (void)hipGetLastError();
        grid = cus;
    }
    if (grid < 0) return;
    (void)hipMemsetAsync((char*)d_ws + WS_CTL, 0, CTL_BYTES, stream);
    Args a{};
    for (int i = 0; i < 21; ++i) a.in[i] = (const float*)d_in[i];
    a.out = (float*)d_out; a.ws = (unsigned char*)d_ws;
#if MK_N_LAUNCHES == 1
    a.ph_lo = 0; a.ph_hi = NPHASE;
    hipLaunchKernelGGL(fwd, dim3(grid), dim3(512), LDS_BYTES, stream, a);
#else
    for (int p = 0; p < NPHASE; ++p) { a.ph_lo = p; a.ph_hi = p + 1; hipLaunchKernelGGL(fwd, dim3(grid), dim3(512), LDS_BYTES, stream, a); }
#endif
    (void)in_sizes;
}
```

```cpp
#include <hip/hip_runtime.h>
#include <cstdio>
#include <cstdint>

#ifndef MK_N_LAUNCHES
#define MK_N_LAUNCHES 1
#endif

#define GAS __attribute__((address_space(1)))
#define LAS __attribute__((address_space(3)))
typedef unsigned short bf16;
typedef unsigned v4u __attribute__((ext_vector_type(4)));
typedef unsigned v2u __attribute__((ext_vector_type(2)));
typedef float f32x4 __attribute__((ext_vector_type(4)));
typedef float f32x2 __attribute__((ext_vector_type(2)));
typedef float f32x16 __attribute__((ext_vector_type(16)));
typedef short bf16x8 __attribute__((ext_vector_type(8)));

constexpr int T = 16384, D = 2048, SEQ = 2048;
constexpr int NPROJ = 18432;
constexpr int PC_Z = 8192, PC_P = 12288, PC_GA = 14336, PC_GP = 16384;
constexpr int NWIN_T = 18688;
constexpr int NH = 32, HD = 128;
constexpr int NE = 32, TOPK = 4, DE = 2048;
constexpr int KCAT = 6144;
constexpr int LDX = 2048 + 64;
constexpr int RMAX = 65536 + 32 * 256;
constexpr float RMS_EPS = 1e-6f, L2_EPS = 1e-6f;

constexpr size_t MiB = 1u << 20;
constexpr size_t al(size_t x) { return (x + MiB - 1) / MiB * MiB; }
constexpr size_t WS_CTL = 0, CTL_BYTES = 1 * MiB;
constexpr size_t WS_ROUTE = WS_CTL + CTL_BYTES;
constexpr size_t RT_E = 0, RT_SLOT = 262144, RT_GATE = 524288, RT_ROWS = 786432, RT_RSTD = 1048576, RT_TILEE = 1114112, RT_RWT = 1179648  , RT_ROWTOK = 1441792  , ROUTE_BYTES = 2 * MiB;
constexpr size_t WS_WIN = WS_ROUTE + ROUTE_BYTES;
constexpr size_t WS_WCAT = WS_WIN + al((size_t)NWIN_T * LDX * 2);
constexpr size_t WS_WPOOL = WS_WCAT + al((size_t)D * KCAT * 2);
constexpr size_t WS_WOUT = WS_WPOOL + al((size_t)D * 512 * 2);
constexpr size_t WS_W1 = WS_WOUT + al((size_t)D * D * 2);
constexpr size_t WS_W2 = WS_W1 + al((size_t)NE * 2 * DE * D * 2);
constexpr size_t WS_XN = WS_W2 + al((size_t)NE * D * DE * 2);
constexpr size_t WS_PROJ = WS_XN + al((size_t)T * LDX * 2);
constexpr size_t WS_XBUF = WS_PROJ, WS_ACT = WS_PROJ + (size_t)RMAX * D * 2;
constexpr size_t WS_TOKMAP = WS_XBUF + 64 * MiB;
static_assert((size_t)T * D <= 64 * MiB && WS_TOKMAP + (size_t)NE * T * 4 <= WS_ACT, "XQ | TOKMAP inside the XBUF region");
constexpr size_t WS_AB = WS_PROJ + al((size_t)T * NPROJ * 2);
constexpr size_t WS_CONV = WS_AB + al((size_t)T * 256 * 4);
constexpr size_t WS_Y = WS_CONV;
constexpr size_t CONV_K = (size_t)8 * 16 * 2048 * 128, CONV_V = 2 * CONV_K;
constexpr size_t WS_MIXED = WS_CONV + al((size_t)T * 8192 * 2);
constexpr size_t WS_OCAT = WS_MIXED + al((size_t)T * D * 2);
constexpr size_t WS_H = WS_OCAT + al((size_t)T * KCAT * 2);
constexpr size_t WS_X1 = WS_H + al((size_t)T * D * 2);
constexpr size_t WS_DT = WS_X1 + al((size_t)T * D * 4);
constexpr size_t WS_DQK = WS_DT + al((size_t)8192 * 4096 * 2);
constexpr size_t WS_DSC = WS_DQK + al((size_t)8192 * 4096 * 2);
constexpr size_t WS_END = WS_DSC + al((size_t)8192 * 3 * 64 * 4);
static_assert((size_t)2 * RMAX * D * 2 <= (size_t)T * NPROJ * 2, "XBUF|ACT overlay PROJ");
static_assert((size_t)RMAX * D * 2 <= WS_H - WS_CONV, "Y overlays CONV|MIXED|OCAT");
constexpr int CW_BAR = 4096;
constexpr int CW_CNT = 16384;
constexpr int CW_NTILES = 32768;

constexpr int RING_BYTES = 131072;
constexpr int LDS_BYTES = 163840;
constexpr int MISC_OFF = LDS_BYTES - 256;

#define LDS_WAIT() asm volatile("s_waitcnt lgkmcnt(0)" ::: "memory")
#define VM_WAIT() asm volatile("s_waitcnt vmcnt(0)" ::: "memory")
__device__ __forceinline__ unsigned f2bf(float f) { unsigned u = __builtin_bit_cast(unsigned, f); return (u + 0x7fffu + ((u >> 16) & 1u)) >> 16; }
typedef __bf16 bf16x2_t __attribute__((ext_vector_type(2)));
__device__ __forceinline__ unsigned pk2(float lo, float hi) { const f32x2 v = {lo, hi}; const bf16x2_t b = __builtin_convertvector(v, bf16x2_t); return __builtin_bit_cast(unsigned, b); }
constexpr float F8_SX = 32.f, F8_SW = 2048.f, F8_SA = 4.f, F8_SY = 32.f;
__device__ __forceinline__ unsigned pk4_f8(float a, float b, float c, float d) { int w = __builtin_amdgcn_cvt_pk_fp8_f32(a, b, 0, false); w = __builtin_amdgcn_cvt_pk_fp8_f32(c, d, w, true); return (unsigned)w; }
__device__ __forceinline__ f32x4 f8x4(unsigned u) { const f32x2 lo = __builtin_amdgcn_cvt_pk_f32_fp8((int)u, false), hi = __builtin_amdgcn_cvt_pk_f32_fp8((int)u, true); return (f32x4){lo.x, lo.y, hi.x, hi.y}; }
__device__ __forceinline__ float bflo(unsigned u) { return __builtin_bit_cast(float, u << 16); }
__device__ __forceinline__ float bfhi(unsigned u) { return __builtin_bit_cast(float, u & 0xffff0000u); }
__device__ __forceinline__ float wave_sum(float v) {
#pragma unroll
    for (int o = 1; o < 64; o <<= 1) v += __shfl_xor(v, o);
    return v;
}
template <int CTRL> __device__ __forceinline__ float dppf(float v) { return __builtin_bit_cast(float, __builtin_amdgcn_update_dpp(0, __builtin_bit_cast(int, v), CTRL, 0xF, 0xF, true)); }
__device__ __forceinline__ float sigmoidf_(float x) { return __builtin_amdgcn_rcpf(1.0f + __expf(-x)); }

namespace pg8 {
#define PG8_LAS __attribute__((address_space(3)))
constexpr int BM = 256, BK = 64, HALF = 128, HTB = HALF * BK * 2, STAGE_BYTES = 8 * HTB, NXCD = 8, WGM = 8;
__host__ __device__ __forceinline__ int lds_byte(int r, int c) { const int st = (r >> 4) * 2 + (c >> 5), rr = r & 15, cc = c & 31, ob = rr * 64 + cc * 2; return st * 1024 + (ob ^ (((ob >> 9) & 1) << 5)); }
__host__ __device__ __forceinline__ void stage_rc(int b, int& R, int& C) { const int st = b / 1024, sb = b % 1024, swz = sb ^ (((sb >> 9) & 1) << 5); R = (st >> 1) * 16 + swz / 64; C = (st & 1) * 32 + (swz % 64) / 2; }
__host__ __device__ __forceinline__ int perm32(int rho) { const int n = rho >> 4, i = rho & 15; return 8 * (i >> 2) + 4 * n + (i & 3); }
struct Unit { int pm, pn, part; };
template <int N> __device__ __forceinline__ void wait_l() { static_assert(N >= 0 && N < 16, "lgkmcnt"); asm volatile("s_waitcnt lgkmcnt(%0)" :: "n"(N) : "memory"); }
__device__ __forceinline__ void wait_l_n(int n) {
    switch (n) { case 0: wait_l<0>(); break; case 1: wait_l<1>(); break; case 2: wait_l<2>(); break; case 3: wait_l<3>(); break; case 4: wait_l<4>(); break; case 5: wait_l<5>(); break; case 6: wait_l<6>(); break;
                 case 7: wait_l<7>(); break; case 8: wait_l<8>(); break; case 9: wait_l<9>(); break; case 10: wait_l<10>(); break; case 11: wait_l<11>(); break; case 12: wait_l<12>(); break; default: wait_l<0>(); break; } }

template <int MODE> struct Sched {
    static constexpr bool GATHER = (MODE == 4);
    int nM, nN, nwg, G, c, ntk; const char* A; const char* B; size_t tA, tB; const PG8_LAS int* tile_e  ; size_t estride; const int* rowtok; const PG8_LAS int* tbase  ; unsigned tokmax; size_t bdelta1  ;
    __device__ __forceinline__ void init(int nM_, int nN_, int G_, int c_, int ntk_) { nM = nM_; nN = nN_; nwg = nM * nN; G = G_; c = c_; ntk = ntk_; }
    __device__ __forceinline__ bool next(int i, Unit& u) const {
        u.part = (MODE == 3) ? (i & 1) : 0;
        const long L = (long)((MODE == 3) ? (i >> 1) : i) * G + c; if (L >= nwg) return false;
        int wgid = (int)L; { const int q = nwg / NXCD, r = nwg % NXCD, xcd = wgid % NXCD, off = wgid / NXCD; wgid = (xcd < r ? xcd * (q + 1) : r * (q + 1) + (xcd - r) * q) + off; }
        const int nig = WGM * nN, gid = wgid / nig, fm = gid * WGM, gsz = (nM - fm) < WGM ? (nM - fm) : WGM;
        u.pm = fm + ((wgid % nig) % gsz); u.pn = (wgid % nig) / gsz; return true;
    }
    __device__ __forceinline__ int nt(const Unit& u) const { return (MODE == 3) ? (u.part ? 32 : 64) : ntk; }
    __device__ __forceinline__ const char* a_ptr(const Unit& u) const { if (MODE == 4) return A; const char* p = A + (size_t)u.pm * tA; if (MODE == 1) p += (size_t)(u.pn >> 1) * 1024; if (MODE == 3) p += (size_t)u.part * 8192; return p; }
    __device__ __forceinline__ const char* b_ptr(const Unit& u) const { const char* p = B + (size_t)u.pn * tB; if (MODE == 2 || MODE == 4) p += (size_t)tile_e[u.pm] * estride; if (MODE == 3) p += (size_t)u.part * (8192 + bdelta1); return p; }
};

typedef int v8i_t __attribute__((ext_vector_type(8)));
typedef int v4i_t __attribute__((ext_vector_type(4)));
__device__ __forceinline__ v8i_t cat16(bf16x8 a, bf16x8 b) { return __builtin_shufflevector(__builtin_bit_cast(v4i_t, a), __builtin_bit_cast(v4i_t, b), 0, 1, 2, 3, 4, 5, 6, 7); }
constexpr int P1_N1 = 22, P1_N2 = 7; static_assert(24 * P1_N1 + 8 * P1_N2 == 584, "in-projection unit split");
struct SchedP1 {
    static constexpr bool GATHER = false;
    int xcd, j; const char* A; const char* B; size_t tA, tB; const int* rowtok = nullptr; const PG8_LAS int* tbase = nullptr; unsigned tokmax = 0;
    __device__ __forceinline__ bool next(int i, Unit& u) const {
        u.part = 0; int sidx;
        if (j < 24) { if (i >= P1_N1) return false; sidx = 24 * i + j; } else { if (i >= P1_N2) return false; sidx = 24 * P1_N1 + 8 * i + (j - 24); }
        u.pm = 8 * xcd + (sidx & 7); u.pn = sidx >> 3; return true;
    }
    __device__ __forceinline__ int nt(const Unit&) const { return D / 64; }
    __device__ __forceinline__ const char* a_ptr(const Unit& u) const { return A + (size_t)u.pm * tA; }
    __device__ __forceinline__ const char* b_ptr(const Unit& u) const { return B + (size_t)u.pn * tB; }
};
template <class Epi, class Sch, bool ALIGN_EPI, bool SP2, bool F8 = false>
__device__ __forceinline__ void gemm_phase(PG8_LAS unsigned char* lds, const int lda, const int ldb, const Sch& S, const Epi& E) {
    const int tid = threadIdx.x, wid = __builtin_amdgcn_readfirstlane(tid >> 6), lane = tid & 63, wr = wid >> 2, wc = wid & 3, fr = lane & 15, fq = lane >> 4;
    unsigned voffA[2], voffB[2];
#pragma unroll
    for (int i = 0; i < 2; ++i) { int R, C; stage_rc(tid * 16 + i * 8192, R, C); const int Rb = Epi::PERM ? ((R & ~31) + perm32(R & 31)) : R;
        voffA[i] = (unsigned)(R * lda + C) * 2u; voffB[i] = (unsigned)(Rb * ldb + C) * 2u; }
    constexpr bool GATHER = Sch::GATHER; static_assert(!GATHER || SP2, "gather: SP2 loop only");
    unsigned gA[2][2]; int gR[2], gC[2];
    if constexpr (GATHER) {
#pragma unroll
        for (int i = 0; i < 2; ++i) { int R, C; stage_rc(tid * 16 + i * 8192, R, C); gR[i] = R; gC[i] = C * 2; }
    }
#define PG8_RT_LDS(par_) ((const PG8_LAS int*)(lds + STAGE_BYTES + 2048 + ((par_) & 1) * 1024))
#define PG8_RT_DMA(u_, par_) do { if (wid == 0) __builtin_amdgcn_global_load_lds((const unsigned*)(S.rowtok + S.tbase[(u_).pm] + lane * 4), (PG8_LAS unsigned*)(lds + STAGE_BYTES + 2048 + ((par_) & 1) * 1024), 16, 0, 0); } while (0)
#define PG8_RT_PICK(par_) do { _Pragma("unroll") for (int h_ = 0; h_ < 2; ++h_) _Pragma("unroll") for (int i_ = 0; i_ < 2; ++i_) { const unsigned tk_ = (unsigned)PG8_RT_LDS(par_)[gR[i_] + 128 * h_]; gA[h_][i_] = (tk_ < S.tokmax ? tk_ : S.tokmax) * (unsigned)(lda * 2) + (unsigned)gC[i_]; } } while (0)
    const size_t kstep = (size_t)(BK * 2);
    const size_t hstepA = GATHER ? (size_t)0 : (size_t)HALF * lda * 2, hstepB = (size_t)HALF * ldb * 2;
    const unsigned ldsw = (unsigned)wid * 1024u;
    const int aoff = lds_byte(wr * 64 + fr, fq * 8), boff = lds_byte(wc * 32 + fr, fq * 8);
#define PG8_SA(b, h) (((b) * 2 + (h)) * HTB)
#define PG8_SB(b, h) ((4 + (b) * 2 + (h)) * HTB)
#define PG8_STAGE(bufoff, gbase, voff) do { _Pragma("unroll") for (int _i = 0; _i < 2; ++_i) \
        __builtin_amdgcn_global_load_lds((const unsigned*)((const char*)(gbase) + (voff)[_i]), (PG8_LAS unsigned*)(lds + (bufoff) + ldsw + _i * 8192), 16, 0, 0); } while (0)
#define PG8_STAGE_A(b, h, kp) do { if constexpr (GATHER) PG8_STAGE(PG8_SA(b, h), (kp), gA[h]); else PG8_STAGE(PG8_SA(b, h), (kp) + (h) * hstepA, voffA); } while (0)
#define PG8_LDA(dst, b, h) do { if constexpr (F8) { _Pragma("unroll") for (int m = 0; m < 4; ++m) { dst##8[m].lo = *(const PG8_LAS v4i_t*)(lds + PG8_SA(b, h) + aoff + m * 2048); dst##8[m].hi = *(const PG8_LAS v4i_t*)(lds + PG8_SA(b, h) + aoff + m * 2048 + 1024); } } else { \
        _Pragma("unroll") for (int m = 0; m < 4; ++m) _Pragma("unroll") for (int k = 0; k < 2; ++k) dst[m][k] = *(const PG8_LAS bf16x8*)(lds + PG8_SA(b, h) + aoff + m * 2048 + k * 1024); } } while (0)
#define PG8_LDB(dst, b, h) do { if constexpr (F8) { _Pragma("unroll") for (int n = 0; n < 2; ++n) { dst##8[n].lo = *(const PG8_LAS v4i_t*)(lds + PG8_SB(b, h) + boff + n * 2048); dst##8[n].hi = *(const PG8_LAS v4i_t*)(lds + PG8_SB(b, h) + boff + n * 2048 + 1024); } } else { \
        _Pragma("unroll") for (int n = 0; n < 2; ++n) _Pragma("unroll") for (int k = 0; k < 2; ++k) dst[n][k] = *(const PG8_LAS bf16x8*)(lds + PG8_SB(b, h) + boff + n * 2048 + k * 1024); } } while (0)
#define PG8_MMA(ai, bj, At, Bt) do { __builtin_amdgcn_s_setprio(1); if constexpr (F8) { _Pragma("unroll") for (int m = 0; m < 4; ++m) _Pragma("unroll") for (int n = 0; n < 2; ++n) \
        asm volatile("v_mfma_scale_f32_16x16x128_f8f6f4 %0, %1, %2, %0, %3, %3 op_sel_hi:[0,0,0]" : "+v"(acc[ai][bj][m][n]) : "v"(Bt##8[n]), "v"(At##8[m]), "v"(f8scale)); } else { \
        _Pragma("unroll") for (int m = 0; m < 4; ++m) _Pragma("unroll") for (int n = 0; n < 2; ++n) _Pragma("unroll") for (int k = 0; k < 2; ++k) \
        acc[ai][bj][m][n] = __builtin_amdgcn_mfma_f32_16x16x32_bf16(Bt[n][k], At[m][k], acc[ai][bj][m][n], 0, 0, 0); } __builtin_amdgcn_s_setprio(0); } while (0)
#define PG8_WAIT_V(n) asm volatile("s_waitcnt vmcnt(" #n ")" ::: "memory")
#define PG8_WAIT_L(n) asm volatile("s_waitcnt lgkmcnt(" #n ")" ::: "memory")
#define PG8_BAR __builtin_amdgcn_s_barrier()
#define PG8_SCHED __builtin_amdgcn_sched_barrier(0)
    Unit cur, nxt; int ui = 0;
    if (!S.next(0, cur)) return;
    f32x4 acc[2][2][4][2];
#pragma unroll
    for (int a = 0; a < 2; ++a)
#pragma unroll
        for (int b = 0; b < 2; ++b)
#pragma unroll
            for (int m = 0; m < 4; ++m)
#pragma unroll
                for (int n = 0; n < 2; ++n) acc[a][b][m][n] = (f32x4){0.f, 0.f, 0.f, 0.f};
    bf16x8 At[4][2], B0[2][2], B1[2][2]; v8i_t At8[4], B08[2], B18[2]; int f8scale = 0x7F7F7F7F; asm volatile("" : "+v"(f8scale));
    const char* cA = S.a_ptr(cur); const char* cB = S.b_ptr(cur);
#define PG8_BIAS_DMA(u_, ui_) do { if constexpr (Epi::LDS_BIAS) { if (wid == 0) __builtin_amdgcn_global_load_lds((const unsigned*)(E.bias_src(u_) + lane * 4), (PG8_LAS unsigned*)(lds + STAGE_BYTES + ((ui_) & 1) * 1024), 16, 0, 0); } } while (0)
    if constexpr (GATHER) { PG8_RT_DMA(cur, 0); PG8_WAIT_V(0); PG8_BAR; PG8_RT_PICK(0); PG8_WAIT_L(0); }
    PG8_BIAS_DMA(cur, 0);
    if constexpr (SP2) {
        PG8_STAGE(PG8_SB(0, 0), cB, voffB); PG8_STAGE(PG8_SB(0, 1), cB + hstepB, voffB); PG8_STAGE_A(0, 0, cA); PG8_STAGE_A(0, 1, cA);
        if (wr == 1) PG8_BAR;
        PG8_WAIT_V(2); PG8_BAR;
        PG8_STAGE(PG8_SB(1, 0), cB + kstep, voffB); PG8_STAGE_A(1, 0, cA + kstep); PG8_STAGE(PG8_SB(1, 1), cB + hstepB + kstep, voffB);
        PG8_WAIT_V(6); PG8_BAR;
    } else {
        PG8_STAGE(PG8_SB(0, 0), cB, voffB); PG8_STAGE(PG8_SA(0, 0), cA, voffA); PG8_STAGE(PG8_SB(0, 1), cB + hstepB, voffB); PG8_STAGE(PG8_SA(0, 1), cA + hstepA, voffA);
        if (wr == 1) PG8_BAR;
        PG8_WAIT_V(4); PG8_BAR;
        PG8_STAGE(PG8_SB(1, 0), cB + kstep, voffB); PG8_STAGE(PG8_SA(1, 0), cA + kstep, voffA); PG8_STAGE(PG8_SB(1, 1), cB + hstepB + kstep, voffB);
        PG8_WAIT_V(6); PG8_BAR;
    }
    for (;;) {
        const bool has_next = S.next(ui + 1, nxt);
        const char* nA = has_next ? S.a_ptr(nxt) : cA; const char* nB = has_next ? S.b_ptr(nxt) : cB;
        if constexpr (GATHER) { if (has_next) PG8_RT_DMA(nxt, ui + 1); }
        const int nt = S.nt(cur);
        for (int t = 0; t < nt; t += 2) {
            const bool last = (t == nt - 2);
            const char* a1 = cA + (size_t)(t + 1) * kstep;
            const char* a2 = last ? nA : cA + (size_t)(t + 2) * kstep; const char* b2 = last ? nB : cB + (size_t)(t + 2) * kstep;
            const char* a3 = a2 + kstep; const char* b3 = b2 + kstep;
            if constexpr (SP2) {
            PG8_LDB(B0, 0, 0); PG8_LDB(B1, 0, 1); PG8_SCHED; PG8_LDA(At, 0, 0); PG8_STAGE_A(1, 1, a1);
            if constexpr (GATHER) { if (last && has_next) PG8_RT_PICK(ui + 1); }
            PG8_WAIT_V(8); PG8_WAIT_L(0); PG8_BAR; PG8_MMA(0, 0, At, B0); PG8_MMA(0, 1, At, B1); PG8_BAR; PG8_SCHED;
            PG8_LDA(At, 0, 1); PG8_STAGE(PG8_SB(0, 0), b2, voffB); PG8_STAGE(PG8_SB(0, 1), b2 + hstepB, voffB); PG8_STAGE_A(0, 0, a2);
            PG8_WAIT_V(8); PG8_WAIT_L(0); PG8_BAR; PG8_MMA(1, 0, At, B0); PG8_MMA(1, 1, At, B1); PG8_BAR; PG8_SCHED;
            PG8_LDB(B0, 1, 0); PG8_LDB(B1, 1, 1); PG8_SCHED; PG8_LDA(At, 1, 0); PG8_STAGE_A(0, 1, a2);
            PG8_WAIT_V(8); PG8_WAIT_L(0); PG8_BAR; PG8_MMA(0, 0, At, B0); PG8_MMA(0, 1, At, B1); PG8_BAR; PG8_SCHED;
            PG8_LDA(At, 1, 1); PG8_STAGE(PG8_SB(1, 0), b3, voffB); PG8_STAGE(PG8_SB(1, 1), b3 + hstepB, voffB); PG8_STAGE_A(1, 0, a3);
            PG8_WAIT_V(8); PG8_WAIT_L(0); PG8_BAR; PG8_MMA(1, 0, At, B0); PG8_MMA(1, 1, At, B1); PG8_BAR; PG8_SCHED;
            } else {
            PG8_LDB(B0, 0, 0); PG8_SCHED; PG8_LDA(At, 0, 0); PG8_STAGE(PG8_SA(1, 1), a1 + hstepA, voffA);
            PG8_WAIT_L(8); PG8_BAR; PG8_WAIT_L(0); PG8_MMA(0, 0, At, B0); PG8_BAR; PG8_SCHED;
            PG8_LDB(B1, 0, 1); PG8_STAGE(PG8_SB(0, 0), b2, voffB);
            PG8_BAR; PG8_WAIT_L(0); PG8_MMA(0, 1, At, B1); PG8_BAR;
            PG8_LDA(At, 0, 1); PG8_STAGE(PG8_SA(0, 0), a2, voffA);
            PG8_BAR; PG8_WAIT_L(0); PG8_MMA(1, 0, At, B0); PG8_BAR; PG8_SCHED;
            PG8_STAGE(PG8_SB(0, 1), b2 + hstepB, voffB);
            PG8_WAIT_V(6); PG8_BAR; PG8_MMA(1, 1, At, B1); PG8_BAR;
            PG8_LDB(B0, 1, 0); PG8_SCHED; PG8_LDA(At, 1, 0); PG8_STAGE(PG8_SA(0, 1), a2 + hstepA, voffA);
            PG8_WAIT_L(8); PG8_BAR; PG8_WAIT_L(0); PG8_MMA(0, 0, At, B0); PG8_BAR; PG8_SCHED;
            PG8_LDB(B1, 1, 1); PG8_STAGE(PG8_SB(1, 0), b3, voffB);
            PG8_BAR; PG8_WAIT_L(0); PG8_MMA(0, 1, At, B1); PG8_BAR;
            PG8_LDA(At, 1, 1); PG8_STAGE(PG8_SA(1, 0), a3, voffA);
            PG8_BAR; PG8_WAIT_L(0); PG8_MMA(1, 0, At, B0); PG8_BAR; PG8_SCHED;
            PG8_STAGE(PG8_SB(1, 1), b3 + hstepB, voffB);
            PG8_WAIT_V(6); PG8_BAR; PG8_MMA(1, 1, At, B1); PG8_BAR;
            }
        }
        if constexpr (ALIGN_EPI) { if (wr == 0) PG8_BAR; }
        if constexpr (F8) asm volatile("s_nop 15\n\ts_nop 15" ::: "memory");
        E(acc, cur, wr, wc, fr, fq, (const PG8_LAS float*)(lds + STAGE_BYTES + (ui & 1) * 1024));
        if (!has_next) break;
        if (!Epi::SELF_ZERO && !E.keep(cur)) {
#pragma unroll
        for (int a = 0; a < 2; ++a)
#pragma unroll
            for (int b = 0; b < 2; ++b)
#pragma unroll
                for (int m = 0; m < 4; ++m)
#pragma unroll
                    for (int n = 0; n < 2; ++n) acc[a][b][m][n] = (f32x4){0.f, 0.f, 0.f, 0.f};
        }
        cur = nxt; cA = nA; cB = nB; ++ui;
        PG8_BIAS_DMA(cur, ui);
        if constexpr (ALIGN_EPI) { if (wr == 1) PG8_BAR; }
    }
    PG8_WAIT_V(0);
    if constexpr (!ALIGN_EPI) { if (wr == 0) PG8_BAR; }
    PG8_BAR;
#undef PG8_BIAS_DMA
#undef PG8_SA
#undef PG8_SB
#undef PG8_STAGE
#undef PG8_STAGE_A
#undef PG8_RT_LDS
#undef PG8_RT_DMA
#undef PG8_RT_PICK
#undef PG8_LDA
#undef PG8_LDB
#undef PG8_MMA
#undef PG8_WAIT_V
#undef PG8_WAIT_L
#undef PG8_BAR
#undef PG8_SCHED
}

#define ACC_T f32x4 (&acc)[2][2][4][2]
#define EPI_ZERO(ai_, m_) do { acc[ai_][0][m_][0] = (f32x4){0.f, 0.f, 0.f, 0.f}; acc[ai_][0][m_][1] = (f32x4){0.f, 0.f, 0.f, 0.f}; acc[ai_][1][m_][0] = (f32x4){0.f, 0.f, 0.f, 0.f}; acc[ai_][1][m_][1] = (f32x4){0.f, 0.f, 0.f, 0.f}; __builtin_amdgcn_sched_barrier(0); } while (0)
struct EpiProj {
    static constexpr bool PERM = true; static constexpr bool LDS_BIAS = false; static constexpr bool SELF_ZERO = true;
    bf16* O; float* AB;
    __device__ __forceinline__ bool keep(const Unit&) const { return false; }
    __device__ __forceinline__ void operator()(ACC_T, const Unit& u, int wr, int wc, int fr, int fq, const PG8_LAS float* blds) const {
        const int row0 = u.pm * BM + wr * 64 + fr;
        if (u.pn < 72) {
            const int col0 = u.pn * BM + wc * 32 + 8 * fq;
#pragma unroll
            for (int ai = 0; ai < 2; ++ai)
#pragma unroll
                for (int m = 0; m < 4; ++m) { bf16* rowp = O + (size_t)(row0 + ai * HALF + m * 16) * NPROJ + col0;
#pragma unroll
                    for (int bj = 0; bj < 2; ++bj) { const f32x4 v0 = acc[ai][bj][m][0], v1 = acc[ai][bj][m][1];
                        v4u w; w.x = pk2(v0[0], v0[1]); w.y = pk2(v0[2], v0[3]); w.z = pk2(v1[0], v1[1]); w.w = pk2(v1[2], v1[3]);
                        *(v4u*)(rowp + bj * HALF) = w; }
                    EPI_ZERO(ai, m); }
        } else {
            const int col0 = wc * 32 + 8 * fq;
#pragma unroll
            for (int ai = 0; ai < 2; ++ai)
#pragma unroll
                for (int m = 0; m < 4; ++m) { float* rowp = AB + (size_t)(row0 + ai * HALF + m * 16) * 256 + col0;
#pragma unroll
                    for (int bj = 0; bj < 2; ++bj) { *(f32x4*)(rowp + bj * HALF) = acc[ai][bj][m][0]; *(f32x4*)(rowp + bj * HALF + 4) = acc[ai][bj][m][1]; }
                    EPI_ZERO(ai, m); }
        }
    }
};
struct EpiPool {
    static constexpr bool PERM = true; static constexpr bool LDS_BIAS = false; static constexpr bool SELF_ZERO = false;
    bf16* O; const float* scale;
    __device__ __forceinline__ bool keep(const Unit&) const { return false; }
    __device__ __forceinline__ void operator()(ACC_T, const Unit& u, int wr, int wc, int fr, int fq, const PG8_LAS float* blds) const {
        const int row0 = u.pm * BM + wr * 64 + fr, col0 = u.pn * BM + wc * 32 + 8 * fq;
        f32x4 sv[2][2];
#pragma unroll
        for (int bj = 0; bj < 2; ++bj)
#pragma unroll
            for (int n = 0; n < 2; ++n) sv[bj][n] = *(const f32x4*)(scale + col0 + bj * HALF + 4 * n);
#pragma unroll
        for (int ai = 0; ai < 2; ++ai)
#pragma unroll
            for (int m = 0; m < 4; ++m) { bf16* rowp = O + (size_t)(row0 + ai * HALF + m * 16) * KCAT + 4096 + col0;
#pragma unroll
                for (int bj = 0; bj < 2; ++bj) { const f32x4 v0 = acc[ai][bj][m][0] * sv[bj][0], v1 = acc[ai][bj][m][1] * sv[bj][1];
                    v4u w; w.x = pk2(v0[0], v0[1]); w.y = pk2(v0[2], v0[3]); w.z = pk2(v1[0], v1[1]); w.w = pk2(v1[2], v1[3]);
                    *(v4u*)(rowp + bj * HALF) = w; } }
    }
};
struct EpiFold {
    static constexpr bool PERM = true; static constexpr bool LDS_BIAS = false; static constexpr bool SELF_ZERO = true;
    bf16* O;
    __device__ __forceinline__ bool keep(const Unit&) const { return false; }
    __device__ __forceinline__ void operator()(ACC_T, const Unit& u, int wr, int wc, int fr, int fq, const PG8_LAS float* blds) const {
        const int row0 = u.pm * BM + wr * 64 + fr, col0 = u.pn * BM + wc * 32 + 8 * fq;
#pragma unroll
        for (int ai = 0; ai < 2; ++ai)
#pragma unroll
            for (int m = 0; m < 4; ++m) { bf16* rowp = O + (size_t)(row0 + ai * HALF + m * 16) * KCAT + 4096 + col0;
#pragma unroll
                for (int bj = 0; bj < 2; ++bj) { const f32x4 v0 = acc[ai][bj][m][0], v1 = acc[ai][bj][m][1];
                    v4u w; w.x = pk2(v0[0], v0[1]); w.y = pk2(v0[2], v0[3]); w.z = pk2(v1[0], v1[1]); w.w = pk2(v1[2], v1[3]);
                    *(v4u*)(rowp + bj * HALF) = w; }
                EPI_ZERO(ai, m); }
    }
};
struct EpiBranch {
    static constexpr bool PERM = true; static constexpr bool LDS_BIAS = false; static constexpr bool SELF_ZERO = false;
    bf16* Hh; const bf16* PROJ; const float* bgate;
    __device__ __forceinline__ bool keep(const Unit& u) const { return u.part == 0; }
    __device__ __forceinline__ void operator()(ACC_T, const Unit& u, int wr, int wc, int fr, int fq, const PG8_LAS float* blds) const {
        const int row0 = u.pm * BM + wr * 64 + fr, col0 = u.pn * BM + wc * 32 + 8 * fq;
        const f32x2 NL2 = {-1.44269504f, -1.44269504f}, ONE2 = {1.f, 1.f};
#define EB_CL(v) fminf(fmaxf((v), -30.f), 30.f)
        if (u.part == 0) {
#pragma unroll
        for (int bj = 0; bj < 2; ++bj) {
            const f32x4 ba0 = *(const f32x4*)(bgate + col0 + bj * HALF), ba1 = *(const f32x4*)(bgate + col0 + bj * HALF + 4);
            const f32x4 bp0 = *(const f32x4*)(bgate + D + col0 + bj * HALF), bp1 = *(const f32x4*)(bgate + D + col0 + bj * HALF + 4);
            const f32x2 BA[4] = {(f32x2){ba0[0], ba0[1]}, (f32x2){ba0[2], ba0[3]}, (f32x2){ba1[0], ba1[1]}, (f32x2){ba1[2], ba1[3]}};
            const f32x2 BP[4] = {(f32x2){bp0[0], bp0[1]}, (f32x2){bp0[2], bp0[3]}, (f32x2){bp1[0], bp1[1]}, (f32x2){bp1[2], bp1[3]}};
#pragma unroll
            for (int ai = 0; ai < 2; ++ai) {
            v4u gav[4], gpv[4];
#pragma unroll
                for (int m = 0; m < 4; ++m) { const bf16* rowp = PROJ + (size_t)(row0 + ai * HALF + m * 16) * NPROJ + col0 + bj * HALF; gav[m] = *(const v4u*)(rowp + PC_GA); gpv[m] = *(const v4u*)(rowp + PC_GP); }
#pragma unroll
                for (int m = 0; m < 4; ++m) { const v4u ga = gav[m], gp = gpv[m];
#pragma unroll
                    for (int q = 0; q < 4; ++q) {
                        const f32x2 av = (f32x2){bflo(ga[q]), bfhi(ga[q])} + BA[q], pv = (f32x2){bflo(gp[q]), bfhi(gp[q])} + BP[q];
                        const f32x2 ta = (f32x2){EB_CL(av.x), EB_CL(av.y)} * NL2, tp = (f32x2){EB_CL(pv.x), EB_CL(pv.y)} * NL2;
                        const f32x2 da = (f32x2){__builtin_amdgcn_exp2f(ta.x), __builtin_amdgcn_exp2f(ta.y)} + ONE2, dp = (f32x2){__builtin_amdgcn_exp2f(tp.x), __builtin_amdgcn_exp2f(tp.y)} + ONE2;
                        const f32x2 f = dp * (f32x2){__builtin_amdgcn_rcpf(da.x), __builtin_amdgcn_rcpf(da.y)};
                        f32x4& A = acc[ai][bj][m][q >> 1]; const f32x2 v = (f32x2){A[2 * (q & 1)], A[2 * (q & 1) + 1]} * f; A[2 * (q & 1)] = v.x; A[2 * (q & 1) + 1] = v.y; } }
            asm volatile("" ::: "memory");
            }
        }
        } else {
#pragma unroll
        for (int bj = 0; bj < 2; ++bj) {
            const f32x4 bp0 = *(const f32x4*)(bgate + D + col0 + bj * HALF), bp1 = *(const f32x4*)(bgate + D + col0 + bj * HALF + 4);
            const f32x2 BP[4] = {(f32x2){bp0[0], bp0[1]}, (f32x2){bp0[2], bp0[3]}, (f32x2){bp1[0], bp1[1]}, (f32x2){bp1[2], bp1[3]}};
            v4u gpv[2][4];
#pragma unroll
            for (int ai = 0; ai < 2; ++ai)
#pragma unroll
                for (int m = 0; m < 4; ++m) gpv[ai][m] = *(const v4u*)(PROJ + (size_t)(row0 + ai * HALF + m * 16) * NPROJ + PC_GP + col0 + bj * HALF);
#pragma unroll
            for (int ai = 0; ai < 2; ++ai)
#pragma unroll
                for (int m = 0; m < 4; ++m) { const size_t r = (size_t)(row0 + ai * HALF + m * 16); const v4u gp = gpv[ai][m]; v4u w;
#pragma unroll
                    for (int q = 0; q < 4; ++q) {
                        const f32x2 pv = (f32x2){bflo(gp[q]), bfhi(gp[q])} + BP[q];
                        const f32x2 tp = (f32x2){EB_CL(pv.x), EB_CL(pv.y)} * NL2;
                        const f32x2 dp = (f32x2){__builtin_amdgcn_exp2f(tp.x), __builtin_amdgcn_exp2f(tp.y)} + ONE2;
                        const f32x4 A = acc[ai][bj][m][q >> 1]; const f32x2 v = (f32x2){A[2 * (q & 1)], A[2 * (q & 1) + 1]} * (f32x2){__builtin_amdgcn_rcpf(dp.x), __builtin_amdgcn_rcpf(dp.y)};
                        w[q] = pk2(v.x, v.y); }
                    *(v4u*)(Hh + r * D + col0 + bj * HALF) = w; }
            asm volatile("" ::: "memory");
        }
        }
#undef EB_CL
    }
};
struct EpiOut {
    static constexpr bool PERM = true; static constexpr bool LDS_BIAS = false; static constexpr bool SELF_ZERO = true;
    const float* X; bf16* X1;
    __device__ __forceinline__ bool keep(const Unit&) const { return false; }
    __device__ __forceinline__ void operator()(ACC_T, const Unit& u, int wr, int wc, int fr, int fq, const PG8_LAS float* blds) const {
        const size_t ubase = (size_t)(u.pm * BM + wr * 64) * D + u.pn * BM + wc * 32;
        const char* xb = (const char*)(X + ubase); char* ob = (char*)(X1 + ubase);
        const unsigned lx = (unsigned)(fr * D + 8 * fq) * 4u, lo = (unsigned)(fr * D + 8 * fq) * 2u;
#pragma unroll
        for (int ai = 0; ai < 2; ++ai) {
            f32x4 xv[4][2][2];
#pragma unroll
            for (int m = 0; m < 4; ++m)
#pragma unroll
                for (int bj = 0; bj < 2; ++bj)
#pragma unroll
                    for (int n = 0; n < 2; ++n) xv[m][bj][n] = *(const f32x4*)(xb + ((size_t)(ai * HALF + m * 16) * D + bj * HALF + n * 4) * 4 + lx);
#pragma unroll
            for (int m = 0; m < 4; ++m)
#pragma unroll
                for (int bj = 0; bj < 2; ++bj) { const f32x4 v0 = xv[m][bj][0] + acc[ai][bj][m][0], v1 = xv[m][bj][1] + acc[ai][bj][m][1];
                    v4u w; w.x = pk2(v0[0], v0[1]); w.y = pk2(v0[2], v0[3]); w.z = pk2(v1[0], v1[1]); w.w = pk2(v1[2], v1[3]);
                    *(v4u*)(ob + ((size_t)(ai * HALF + m * 16) * D + bj * HALF) * 2 + lo) = w;
                    if (bj == 1) EPI_ZERO(ai, m); }
            asm volatile("" ::: "memory");
        }
    }
};
__device__ __forceinline__ v4u widen16(v2u a, v2u b) {
    const auto rx = __builtin_amdgcn_permlane16_swap(a.x, b.x, false, false); const auto ry = __builtin_amdgcn_permlane16_swap(a.y, b.y, false, false);
    return (v4u){rx[0], ry[0], rx[1], ry[1]};
}
struct EpiSwiglu {
    static constexpr bool PERM = false; static constexpr bool LDS_BIAS = true; static constexpr bool SELF_ZERO = true;
    unsigned char* ACT; const float* b1; const PG8_LAS int* tile_e;
    __device__ __forceinline__ const float* bias_src(const Unit& u) const { return b1 + (size_t)tile_e[u.pm] * (2 * DE) + u.pn * 256; }
    __device__ __forceinline__ bool keep(const Unit&) const { return false; }
    __device__ __forceinline__ void operator()(ACC_T, const Unit& u, int wr, int wc, int fr, int fq, const PG8_LAS float* blds) const {
        const int row0 = u.pm * BM + wr * 64 + fr, o0 = u.pn * 128 + wc * 32 + 8 * fq;
        const PG8_LAS float* bb = blds + 2 * (wc * 32 + 8 * fq);
        const f32x4 q0 = *(const PG8_LAS f32x4*)(bb), q1 = *(const PG8_LAS f32x4*)(bb + 4), q2 = *(const PG8_LAS f32x4*)(bb + 8), q3 = *(const PG8_LAS f32x4*)(bb + 12);
        const f32x4 bg[2] = {(f32x4){q0[0], q0[2], q1[0], q1[2]}, (f32x4){q2[0], q2[2], q3[0], q3[2]}};
        const f32x4 bl[2] = {(f32x4){q0[1], q0[3], q1[1], q1[3]}, (f32x4){q2[1], q2[3], q3[1], q3[3]}};
        const f32x2 S2 = {1.f / (F8_SX * F8_SW), 1.f / (F8_SX * F8_SW)}, C2 = {-1.702f * 1.44269504f, -1.702f * 1.44269504f}, ONE2 = {1.f, 1.f}, SA2 = {F8_SA, F8_SA};
        const int odd = fq & 1;
#pragma unroll
        for (int ai = 0; ai < 2; ++ai)
#pragma unroll
            for (int mp = 0; mp < 2; ++mp) { v2u wq[2];
#pragma unroll
            for (int mm = 0; mm < 2; ++mm) { const int m = 2 * mp + mm; f32x2 r[2][2];
#pragma unroll
                for (int bj = 0; bj < 2; ++bj) { const f32x4 A0 = acc[ai][bj][m][0], A1 = acc[ai][bj][m][1];
#pragma unroll
                    for (int h = 0; h < 2; ++h) {
                        const f32x2 g = (f32x2){A0[2 * h], A0[2 * h + 1]} * S2 + (f32x2){bg[bj][2 * h], bg[bj][2 * h + 1]}, l = (f32x2){A1[2 * h], A1[2 * h + 1]} * S2 + (f32x2){bl[bj][2 * h], bl[bj][2 * h + 1]};
                        const f32x2 xg = {fminf(g.x, 7.0f), fminf(g.y, 7.0f)}, xl = {fminf(fmaxf(l.x, -7.0f), 7.0f), fminf(fmaxf(l.y, -7.0f), 7.0f)};
                        const f32x2 t = xg * C2; const f32x2 d = (f32x2){__builtin_amdgcn_exp2f(t.x), __builtin_amdgcn_exp2f(t.y)} + ONE2;
                        const f32x2 rc = {__builtin_amdgcn_rcpf(d.x), __builtin_amdgcn_rcpf(d.y)};
                        r[bj][h] = (xg * rc) * (xl * SA2 + SA2); } }
                wq[mm].x = pk4_f8(r[0][0].x, r[0][0].y, r[0][1].x, r[0][1].y); wq[mm].y = pk4_f8(r[1][0].x, r[1][0].y, r[1][1].x, r[1][1].y); }
                *(v4u*)(ACT + (size_t)(row0 + ai * HALF + (2 * mp + odd) * 16) * DE + o0 - 8 * odd) = widen16(wq[0], wq[1]);
                EPI_ZERO(ai, 2 * mp); EPI_ZERO(ai, 2 * mp + 1); }
    }
};
struct EpiY {
    static constexpr bool PERM = true; static constexpr bool LDS_BIAS = true; static constexpr bool SELF_ZERO = true;
    unsigned char* Y; const float* b2; const PG8_LAS int* tile_e;
    __device__ __forceinline__ const float* bias_src(const Unit& u) const { return b2 + (size_t)tile_e[u.pm] * D + u.pn * 256; }
    __device__ __forceinline__ bool keep(const Unit&) const { return false; }
    __device__ __forceinline__ void operator()(ACC_T, const Unit& u, int wr, int wc, int fr, int fq, const PG8_LAS float* blds) const {
        const int row0 = u.pm * BM + wr * 64 + fr, col0 = u.pn * BM + wc * 32 + 8 * fq;
        const PG8_LAS float* bb = blds + wc * 32 + 8 * fq;
        f32x4 bv[2][2];
#pragma unroll
        for (int bj = 0; bj < 2; ++bj)
#pragma unroll
            for (int n = 0; n < 2; ++n) bv[bj][n] = *(const PG8_LAS f32x4*)(bb + bj * HALF + 4 * n) * F8_SY;
        const int odd = fq & 1;
#pragma unroll
        for (int ai = 0; ai < 2; ++ai)
#pragma unroll
            for (int mp = 0; mp < 2; ++mp) { v2u wq[2][2];
#pragma unroll
                for (int mm = 0; mm < 2; ++mm)
#pragma unroll
                    for (int bj = 0; bj < 2; ++bj) { const int m = 2 * mp + mm; const f32x4 v0 = acc[ai][bj][m][0] * (F8_SY / (F8_SA * F8_SW)) + bv[bj][0], v1 = acc[ai][bj][m][1] * (F8_SY / (F8_SA * F8_SW)) + bv[bj][1];
                        wq[mm][bj].x = pk4_f8(v0[0], v0[1], v0[2], v0[3]); wq[mm][bj].y = pk4_f8(v1[0], v1[1], v1[2], v1[3]); }
                unsigned char* rowp = Y + (size_t)(row0 + ai * HALF + (2 * mp + odd) * 16) * D + col0 - 8 * odd;
#pragma unroll
                for (int bj = 0; bj < 2; ++bj) *(v4u*)(rowp + bj * HALF) = widen16(wq[0][bj], wq[1][bj]);
                EPI_ZERO(ai, 2 * mp); EPI_ZERO(ai, 2 * mp + 1); }
    }
};
}

#define XB_TMO      128
#define XB_XCNT(j)  (256  + 64 * (j))
#define XB_XSUB(j)  (1280 + 64 * (j))
#define XB_XGEN(j)  (2304 + 64 * (j))
#define XB_TOP      3328
#define XB_TOPGEN   3392
#define XCD_BAR_WORDS 3456
#define XB_SPIN_CAP (1u << 18)
__device__ __forceinline__ unsigned xb_ld(unsigned* p)              { return __hip_atomic_load(p, __ATOMIC_RELAXED, __HIP_MEMORY_SCOPE_AGENT); }
__device__ __forceinline__ unsigned xb_add(unsigned* p, unsigned v) { return __hip_atomic_fetch_add(p, v, __ATOMIC_RELAXED, __HIP_MEMORY_SCOPE_AGENT); }
__device__ __forceinline__ unsigned xb_xcc_id() { return (unsigned)__builtin_amdgcn_s_getreg((3 << 11) | 20) & 0xFu; }
#define XB_SPIN(cond, bar) do { unsigned _sp = 0; while (cond) { __builtin_amdgcn_s_sleep(1); \
    if ((++_sp & 255u) == 0u) { if (xb_ld(&(bar)[XB_TMO])) break; if (_sp > XB_SPIN_CAP) { atomicAdd(&(bar)[XB_TMO], 1u); break; } } } } while (0)
struct XcdBarrier { unsigned* bar; unsigned x; volatile LAS unsigned* st; };
__device__ __forceinline__ XcdBarrier xcd_barrier_post(unsigned* bar, volatile LAS unsigned* st) {
    XcdBarrier b; b.bar = bar; b.x = xb_xcc_id(); b.st = st;
    if (threadIdx.x == 0) (void)xb_add(&bar[XB_XCNT(b.x)], 1u);
    return b;
}
__device__ __forceinline__ void xcd_barrier_complete(unsigned* bar, unsigned x, unsigned& nloc, unsigned& nx) {
    const unsigned G = gridDim.x * gridDim.y * gridDim.z;
    unsigned sum, cnt, mine, sp = 0u;
    for (;;) {
        sum = 0u; cnt = 0u; mine = 0u;
#pragma unroll
        for (unsigned j = 0; j < 16; ++j) { const unsigned c = xb_ld(&bar[XB_XCNT(j)]); sum += c; cnt += (c > 0u) ? 1u : 0u; mine = (j == x) ? c : mine; }
        if (sum == G) break;
        __builtin_amdgcn_s_sleep(1);
        if ((++sp & 255u) == 0u) { if (xb_ld(&bar[XB_TMO])) break; if (sp > XB_SPIN_CAP) { atomicAdd(&bar[XB_TMO], 1u); break; } }
    }
    nloc = mine > 0u ? mine : 1u; nx = cnt > 0u ? cnt : 1u;
}
__device__ __forceinline__ void xcd_barrier(const XcdBarrier& b) {
    asm volatile("s_waitcnt vmcnt(0)" ::: "memory");
    __syncthreads();
    if (threadIdx.x == 0) {
        unsigned* bar = b.bar;
        __builtin_amdgcn_s_waitcnt(0);
        unsigned nloc = b.st[0], nx = b.st[1];
        if (nloc == 0u) { xcd_barrier_complete(bar, b.x, nloc, nx); b.st[0] = nloc; b.st[1] = nx; }
        const unsigned old = xb_add(&bar[XB_XSUB(b.x)], 1u);
        const unsigned gen = old / nloc;
        if (old + 1u == (gen + 1u) * nloc) {
            __builtin_amdgcn_fence(__ATOMIC_RELEASE, "agent");
            asm volatile("s_waitcnt vmcnt(0)" ::: "memory");
            const unsigned og = xb_add(&bar[XB_TOP], 1u);
            const unsigned tg = og / nx;
            if (og + 1u == (tg + 1u) * nx) xb_add(&bar[XB_TOPGEN], 1u);
            else XB_SPIN(xb_ld(&bar[XB_TOPGEN]) == tg, bar);
            __builtin_amdgcn_fence(__ATOMIC_ACQUIRE, "agent");
            xb_add(&bar[XB_XGEN(b.x)], 1u);
            asm volatile("s_waitcnt vmcnt(0)" ::: "memory");
        } else {
            XB_SPIN(xb_ld(&bar[XB_XGEN(b.x)]) == gen, bar);
            __builtin_amdgcn_fence(__ATOMIC_ACQUIRE, "agent");
            asm volatile("s_waitcnt vmcnt(0)" ::: "memory");
        }
    }
    __syncthreads();
}

struct Args { const float* in[21]; float* out; unsigned char* ws; int ph_lo, ph_hi; };
struct Frame {
    LAS unsigned char* lds; unsigned* ctl; unsigned char* ws;
    int tid, lane, wave, vcu, G;
};
enum { I_X = 0, I_N1W, I_WIN, I_BGATE, I_CONVW, I_ALOG, I_DTB, I_ONW, I_WBA, I_WPOOL, I_PSCALE, I_WBP, I_WOUT, I_N2W, I_RW, I_RB, I_W1, I_B1, I_W2, I_B2, I_NFW };

template <int MAP> __device__ __forceinline__ int map_row(int n) {
    if (MAP == 1) return n < 12288 ? n : (n < 12352 ? n + 6144 : n - 64);
    if (MAP == 2) { const int nn = n & 1, o = n >> 1; return ((o >> 7) << 8) + (((o >> 2) & 1) << 7) + (((o >> 5) & 3) << 5) + (nn << 4) + (((o >> 3) & 3) << 2) + (o & 3); }
    return n;
}
template <bool F8> __device__ __forceinline__ void tr_load(f32x4 (&v)[16], const float* __restrict__ W, int N, int k0, int n0, int lane) {
    if (F8) { const int kr = lane >> 3, c4 = lane & 7;
#pragma unroll
        for (int i = 0; i < 16; ++i) v[i] = __builtin_nontemporal_load((const f32x4*)(W + (size_t)(k0 + 8 * i + kr) * N + n0 + 4 * c4));
    } else { const int kr = lane >> 4, c4 = lane & 15;
#pragma unroll
        for (int i = 0; i < 16; ++i) v[i] = __builtin_nontemporal_load((const f32x4*)(W + (size_t)(k0 + 4 * i + kr) * N + n0 + 4 * c4)); }
}
template <bool F8> __device__ __forceinline__ void tr_stage(const f32x4 (&v)[16], LAS float* scr, int lane) {
    if (F8) { const int kr = lane >> 3, c4 = lane & 7;
#pragma unroll
        for (int i = 0; i < 16; ++i) { const int k = 8 * i + kr; *(LAS f32x4*)(scr + k * 36 + 4 * (c4 ^ ((k >> 4) & 7))) = v[i]; }
    } else { const int kr = lane >> 4, c4 = lane & 15;
#pragma unroll
        for (int i = 0; i < 16; ++i) { const int k = 4 * i + kr; *(LAS f32x4*)(scr + k * 68 + 4 * (c4 ^ ((k >> 3) & 7))) = v[i]; }
    }
    LDS_WAIT(); asm volatile("" ::: "memory");
}
template <int MAP, bool F8> __device__ __forceinline__ void tr_emit(void* __restrict__ WTv, int ldd, int koff, int row_off, LAS float* scr, int k0, int n0, int lane) {
    if (F8) {
        unsigned char* WT = (unsigned char*)WTv;
#pragma unroll
        for (int x = 0; x < 4; ++x) { const int c = lane & 7, n = (lane >> 3) + 8 * x; const LAS float* s = scr + (16 * c) * 36 + (n ^ (4 * c));
            v4u o; o.x = pk4_f8(s[0 * 36] * F8_SW, s[1 * 36] * F8_SW, s[2 * 36] * F8_SW, s[3 * 36] * F8_SW); o.y = pk4_f8(s[4 * 36] * F8_SW, s[5 * 36] * F8_SW, s[6 * 36] * F8_SW, s[7 * 36] * F8_SW);
            o.z = pk4_f8(s[8 * 36] * F8_SW, s[9 * 36] * F8_SW, s[10 * 36] * F8_SW, s[11 * 36] * F8_SW); o.w = pk4_f8(s[12 * 36] * F8_SW, s[13 * 36] * F8_SW, s[14 * 36] * F8_SW, s[15 * 36] * F8_SW);
            __builtin_nontemporal_store(o, (v4u*)(WT + (size_t)(row_off + map_row<MAP>(n0 + n)) * ldd + koff + k0 + 16 * c)); }
        LDS_WAIT(); asm volatile("" ::: "memory");
    } else {
        bf16* WT = (bf16*)WTv;
        const int c = lane & 7;
#pragma unroll
        for (int j = 0; j < 8; ++j) { const int n = (lane >> 3) + 8 * j; const LAS float* s = scr + (8 * c) * 68 + (n ^ (4 * c));
            v4u o; o.x = pk2(s[0 * 68], s[1 * 68]); o.y = pk2(s[2 * 68], s[3 * 68]); o.z = pk2(s[4 * 68], s[5 * 68]); o.w = pk2(s[6 * 68], s[7 * 68]);
            *(v4u*)(WT + (size_t)(row_off + map_row<MAP>(n0 + n)) * ldd + koff + k0 + 8 * c) = o; }
        LDS_WAIT(); asm volatile("" ::: "memory");
    }
}
template <int MAP, bool F8> __device__ __forceinline__ void tr_matrix(Frame& F, const float* W, int nbatch, size_t src_stride, int K, int N, void* WT, int ldd, int koff, int row_off, int row_stride, int gw, int NGW) {
    LAS float* scr = (LAS float*)(F.lds + F.wave * 18432);
    constexpr int TK = F8 ? 128 : 64, TN = F8 ? 32 : 64;
    const int nnb = N / TN, nit = (K / TK) * nnb, total = nit * nbatch;
#define TR_DECODE(it_, e_, k0_, n0_) const int e_ = (it_) / nit, r_##e_ = (it_) % nit, k0_ = (r_##e_ / nnb) * TK, n0_ = (r_##e_ % nnb) * TN
    f32x4 va[16], vb[16];
    int it = gw;
    if (it >= total) return;
    { const int i0 = it < total ? it : total - 1; TR_DECODE(i0, e0, k0, n0); tr_load<F8>(va, W + (size_t)e0 * src_stride, N, k0, n0, F.lane); }
    { const int i1 = it + NGW < total ? it + NGW : total - 1; TR_DECODE(i1, e0, k0, n0); tr_load<F8>(vb, W + (size_t)e0 * src_stride, N, k0, n0, F.lane); }
#define TR_STEP(cur) { tr_stage<F8>(cur, scr, F.lane); { const int n2 = it + 2 * NGW < total ? it + 2 * NGW : total - 1; TR_DECODE(n2, e1, k1, n1); tr_load<F8>(cur, W + (size_t)e1 * src_stride, N, k1, n1, F.lane); } \
          TR_DECODE(it, e0, k0, n0); tr_emit<MAP, F8>(WT, ldd, koff, row_off + e0 * row_stride, scr, k0, n0, F.lane); it += NGW; }
    while (it < total) {
        TR_STEP(va); if (it >= total) break;
        TR_STEP(vb);
    }
#undef TR_STEP
#undef TR_DECODE
}
__device__ __forceinline__ void p_convert_experts(Frame& F, const Args& a, int gw, int NGW) {
    tr_matrix<2, true>(F, a.in[I_W1], NE, (size_t)D * 2 * DE, D, 2 * DE, (unsigned char*)(F.ws + WS_W1), D, 0, 0, 2 * DE, gw, NGW);
    tr_matrix<0, true>(F, a.in[I_W2], NE, (size_t)DE * D, DE, D, (unsigned char*)(F.ws + WS_W2), DE, 0, 0, D, gw, NGW);
}
__device__ __forceinline__ void p0_prologue(Frame& F, const Args& a) {
    unsigned char* ws = F.ws;
    const int gw0 = F.vcu * 8 + F.wave, NGW0 = F.G * 8;
#define P0_ROT(cnt_) ((gw0 + NGW0 - (int)((cnt_) % NGW0)) % NGW0)
    tr_matrix<1, false>(F, a.in[I_WIN], 1, 0, D, 18496, (bf16*)(ws + WS_WIN), LDX, 0, 0, 0, gw0, NGW0);
    tr_matrix<0, false>(F, a.in[I_WBA], 1, 0, 4096, D, (bf16*)(ws + WS_WCAT), KCAT, 0, 0, 0, P0_ROT(9248), NGW0);
    tr_matrix<0, false>(F, a.in[I_WBP], 1, 0, D, D, (bf16*)(ws + WS_WCAT), KCAT, 4096, 0, 0, P0_ROT(9248 + 2048), NGW0);
    tr_matrix<0, false>(F, a.in[I_WOUT], 1, 0, D, D, (bf16*)(ws + WS_WOUT), D, 0, 0, 0, P0_ROT(9248 + 2048 + 1024), NGW0);
    {
      const float* WP = a.in[I_WPOOL]; const float* PS = a.in[I_PSCALE]; v2u* BW = (v2u*)(ws + WS_WPOOL);
      for (int i4 = (int)blockIdx.x * 512 + F.tid; i4 < 4 * 512 * 512 / 4; i4 += (int)gridDim.x * 512) { const int g = i4 >> 16, e = (i4 * 4) & 511;
          const f32x4 w = *(const f32x4*)(WP + (size_t)i4 * 4) * *(const f32x4*)(PS + g * 512 + e); v2u o; o.x = pk2(w.x, w.y); o.y = pk2(w.z, w.w); BW[i4] = o; } }
#undef P0_ROT
    if (F.G != 256) p_convert_experts(F, a, gw0, NGW0);
    { float* RWT = (float*)(ws + WS_ROUTE + RT_RWT); const float* RW = a.in[I_RW]; const float* N2 = a.in[I_N2W];
      for (int idx = (int)blockIdx.x * 512 + F.tid; idx < NE * D; idx += (int)gridDim.x * 512) { const int e = idx >> 11, d = idx & (D - 1); const float v = RW[(size_t)d * NE + e] * N2[d];
          const unsigned hb = f2bf(v), lb = f2bf(v - __builtin_bit_cast(float, hb << 16)); ((unsigned short*)RWT)[idx] = (unsigned short)hb; ((unsigned short*)RWT)[NE * D + idx] = (unsigned short)lb; } }
    const int gw = F.vcu * 8 + F.wave, NGW = F.G * 8;
    const float* x = a.in[I_X]; const float* w = a.in[I_N1W]; bf16* XN = (bf16*)(ws + WS_XN);
    f32x4 wv[8];
#pragma unroll
    for (int j = 0; j < 8; ++j) wv[j] = *(const f32x4*)(w + 4 * F.lane + 256 * j);
    f32x4 vnx[8];
    { const int m0 = gw < T ? gw : T - 1; const f32x4* xr = (const f32x4*)(x + (size_t)m0 * D) + F.lane;
#pragma unroll
      for (int j = 0; j < 8; ++j) vnx[j] = xr[64 * j]; }
    for (int m = gw; m < T; m += NGW) {
        f32x4 v[8]; float s = 0.f;
#pragma unroll
        for (int j = 0; j < 8; ++j) v[j] = vnx[j];
        { const int m1 = m + NGW < T ? m + NGW : T - 1; const f32x4* xr = (const f32x4*)(x + (size_t)m1 * D) + F.lane;
#pragma unroll
          for (int j = 0; j < 8; ++j) vnx[j] = xr[64 * j]; }
#pragma unroll
        for (int j = 0; j < 8; ++j) s += (v[j].x * v[j].x + v[j].y * v[j].y) + (v[j].z * v[j].z + v[j].w * v[j].w);
        const float rstd = __frsqrt_rn(wave_sum(s) * (1.f / D) + RMS_EPS);
        v2u* o = (v2u*)(XN + (size_t)m * LDX) + F.lane;
#pragma unroll
        for (int j = 0; j < 8; ++j) { const f32x4 y = v[j] * rstd * wv[j]; v2u p; p.x = pk2(y.x, y.y); p.y = pk2(y.z, y.w); o[64 * j] = p; }
    }
}

__device__ __forceinline__ void p2_prep(Frame& F, const Args& a) {
    const bf16* PROJ = (const bf16*)(F.ws + WS_PROJ); bf16* CONV = (bf16*)(F.ws + WS_CONV); bf16* OCATP = (bf16*)(F.ws + WS_OCAT) + 4096;
    const float* cw = a.in[I_CONVW];
    const int gw = F.vcu * 8 + F.wave, NGW = F.G * 8, lane = F.lane;
    constexpr int NCONV = 128 * 16, NPOOLU = 512 * 4;
    for (int it = gw; it < NCONV; it += NGW) {
            const int tb = it >> 4, cb = it & 15, t0 = tb * 128, c0 = cb * 512 + lane * 8, s0 = t0 & (SEQ - 1);
            f32x2 w[4][4];
#pragma unroll
            for (int i = 0; i < 4; ++i) { const f32x4 w0 = *(const f32x4*)(cw + (size_t)i * 8192 + c0), w1 = *(const f32x4*)(cw + (size_t)i * 8192 + c0 + 4);
                w[i][0] = (f32x2){w0[0], w0[1]}; w[i][1] = (f32x2){w0[2], w0[3]}; w[i][2] = (f32x2){w1[0], w1[1]}; w[i][3] = (f32x2){w1[2], w1[3]}; }
            const bf16* src = PROJ + (size_t)t0 * NPROJ + c0;
            v4u ua[8], ub[8];
#pragma unroll
            for (int k = 0; k < 8; ++k) ua[k] = *(const v4u*)(src + (size_t)k * NPROJ);
            f32x2 h0[4], h1[4], h2[4];
#pragma unroll
            for (int q = 0; q < 4; ++q) { h0[q] = (f32x2){0.f, 0.f}; h1[q] = (f32x2){0.f, 0.f}; h2[q] = (f32x2){0.f, 0.f}; }
            if (s0 > 0) {
                const v4u u0 = *(const v4u*)(src - (size_t)3 * NPROJ), u1 = *(const v4u*)(src - (size_t)2 * NPROJ), u2 = *(const v4u*)(src - (size_t)NPROJ);
#pragma unroll
                for (int q = 0; q < 4; ++q) { h0[q] = (f32x2){bflo(u0[q]), bfhi(u0[q])}; h1[q] = (f32x2){bflo(u1[q]), bfhi(u1[q])}; h2[q] = (f32x2){bflo(u2[q]), bfhi(u2[q])}; }
            }
            const float qs = (cb < 4) ? 0.08838834764831845f : 1.0f;
            bf16* cdst; { const int bb = t0 >> 11, hd = (cb & 3) * 4 + (lane >> 4), dd = (lane & 15) * 8;
                cdst = cb < 4 ? CONV + ((size_t)(bb * 16 + hd) * SEQ + s0) * 128 + dd
                     : cb < 8 ? CONV + CONV_K + ((size_t)(bb * 16 + hd) * SEQ + s0) * 128 + dd
                              : CONV + CONV_V + ((size_t)(bb * 32 + (cb - 8) * 4 + (lane >> 4)) * SEQ + s0) * 128 + dd; }
            const f32x2 NL2 = {-1.44269504f, -1.44269504f}, ONE2 = {1.f, 1.f};
#define CV_BATCH(cur, nxt, tt0_) { const int tn_ = (tt0_) + 8 < 128 ? (tt0_) + 8 : (tt0_);        \
            _Pragma("unroll") for (int k = 0; k < 8; ++k) nxt[k] = *(const v4u*)(src + (size_t)(tn_ + k) * NPROJ); \
            _Pragma("unroll") for (int k = 0; k < 8; ++k) { const int tt = (tt0_) + k; const v4u u = cur[k]; \
                f32x2 y[4]; f32x2 ss2 = {0.f, 0.f}; \
                _Pragma("unroll") for (int q = 0; q < 4; ++q) { const f32x2 xc = {bflo(u[q]), bfhi(u[q])}; \
                    const f32x2 z = w[0][q] * h0[q] + w[1][q] * h1[q] + w[2][q] * h2[q] + w[3][q] * xc; const f32x2 t = z * NL2; \
                    const f32x2 d = (f32x2){__builtin_amdgcn_exp2f(t.x), __builtin_amdgcn_exp2f(t.y)} + ONE2; \
                    y[q] = z * (f32x2){__builtin_amdgcn_rcpf(d.x), __builtin_amdgcn_rcpf(d.y)}; ss2 += y[q] * y[q]; h0[q] = h1[q]; h1[q] = h2[q]; h2[q] = xc; } \
                { float ss = ss2.x + ss2.y; ss += dppf<0xB1>(ss); ss += dppf<0x4E>(ss); ss += dppf<0x141>(ss); ss += dppf<0x140>(ss);        \
                    const float inv = cb < 8 ? __frsqrt_rn(ss + L2_EPS) * qs : 1.0f; const f32x2 inv2 = {inv, inv}; \
                    _Pragma("unroll") for (int q = 0; q < 4; ++q) y[q] *= inv2; } \
                v4u o; o.x = pk2(y[0].x, y[0].y); o.y = pk2(y[1].x, y[1].y); o.z = pk2(y[2].x, y[2].y); o.w = pk2(y[3].x, y[3].y); \
                *(v4u*)(cdst + (size_t)tt * 128) = o; } }
            for (int tt0 = 0; tt0 < 128; tt0 += 16) { CV_BATCH(ua, ub, tt0); CV_BATCH(ub, ua, tt0 + 8); }
#undef CV_BATCH
    }
    for (int it = gw; it < NPOOLU; it += NGW) {
            const int tb = it >> 2, gi = it & 3, t0 = tb * 32, s0 = t0 & (SEQ - 1), win = 2 << gi, c0 = gi * 512 + lane * 8;
            const bf16* P = PROJ + PC_P + c0 + (size_t)t0 * NPROJ;
            v4u ua[8], qa[8], ub[8], qb[8];
#define PL_LOAD(u_, q_, tt0_) { _Pragma("unroll") for (int k = 0; k < 8; ++k) { const int tt = (tt0_) + k; u_[k] = *(const v4u*)(P + (size_t)tt * NPROJ); \
                const int tq = (s0 + tt - win >= 0) ? tt - win : tt; q_[k] = *(const v4u*)(P + (ptrdiff_t)tq * NPROJ); } }
            PL_LOAD(ua, qa, 0);
            f32x2 sum[4];
#pragma unroll
            for (int q = 0; q < 4; ++q) sum[q] = (f32x2){0.f, 0.f};
            if (s0 > 0) {
                v4u hb[16];
#pragma unroll
                for (int d = 1; d <= 16; ++d) { const int dd = d <= win ? d : win; hb[d - 1] = *(const v4u*)(P - (ptrdiff_t)dd * NPROJ); }
#pragma unroll
                for (int d = 1; d <= 16; ++d) { const float mk = d <= win ? 1.f : 0.f; const f32x2 mk2 = {mk, mk};
#pragma unroll
                    for (int q = 0; q < 4; ++q) sum[q] += (f32x2){bflo(hb[d - 1][q]), bfhi(hb[d - 1][q])} * mk2; }
            }
#define PL_BATCH(uc, qc, un, qn, tt0_) { { const int tn_ = (tt0_) + 8 < 32 ? (tt0_) + 8 : (tt0_); PL_LOAD(un, qn, tn_); } \
            _Pragma("unroll") for (int k = 0; k < 8; ++k) { const int tt = (tt0_) + k, sq = s0 + tt; const v4u u = uc[k], qv = qc[k]; \
                const float mk = (sq - win >= 0) ? 1.f : 0.f; const float inv = __builtin_amdgcn_rcpf((float)((sq + 1) < win ? (sq + 1) : win)); const f32x2 mk2 = {mk, mk}, inv2 = {inv, inv}; v4u o; \
                _Pragma("unroll") for (int q = 0; q < 4; ++q) { const f32x2 xc = {bflo(u[q]), bfhi(u[q])}, xo = {bflo(qv[q]), bfhi(qv[q])}; \
                    sum[q] += xc - xo * mk2; const f32x2 y = sum[q] * inv2 - xc; o[q] = pk2(y.x, y.y); } \
                *(v4u*)(OCATP + (size_t)(t0 + tt) * KCAT + c0) = o; } }
            PL_BATCH(ua, qa, ub, qb, 0); PL_BATCH(ub, qb, ua, qa, 8); PL_BATCH(ua, qa, ub, qb, 16); PL_BATCH(ub, qb, ua, qa, 24);
#undef PL_BATCH
#undef PL_LOAD
    }
}

typedef short s16x4 __attribute__((ext_vector_type(4)));
#define MFMA32(a, b, c) __builtin_amdgcn_mfma_f32_32x32x16_bf16((a), (b), (c), 0, 0, 0)
__device__ __forceinline__ bf16x8 ldfrag(const LAS bf16* p) { return *(const LAS bf16x8*)p; }
__device__ __forceinline__ bf16x8 trfrag(const LAS bf16* p0, const LAS bf16* p1) {
    const s16x4 lo = __builtin_amdgcn_ds_read_tr16_b64_v4i16((LAS s16x4*)p0), hi = __builtin_amdgcn_ds_read_tr16_b64_v4i16((LAS s16x4*)p1);
    return __builtin_shufflevector(lo, hi, 0, 1, 2, 3, 4, 5, 6, 7);
}
constexpr int D2_KN = 0, D2_QN = 17408, D2_VN = 34816, D2_KD = 52224, D2_TM = 69632, D2_QKM = 78848, D2_SC = 88064  , D2_PRIV = 91136, D2_PW = 8960;
static_assert(D2_PRIV + 8 * D2_PW <= MISC_OFF, "delta LDS map");
__device__ __forceinline__ void p3_delta(Frame& F, const Args& a) {
    const bf16* CONV = (const bf16*)(F.ws + WS_CONV); const bf16* PROJ = (const bf16*)(F.ws + WS_PROJ); const float* AB = (const float*)(F.ws + WS_AB);
    bf16* OCAT = (bf16*)(F.ws + WS_OCAT);
    bf16* Tg = (bf16*)(F.ws + WS_DT); bf16* QKg = (bf16*)(F.ws + WS_DQK); float* SCg = (float*)(F.ws + WS_DSC);
    const int tid = F.tid, lane = F.lane, w = F.wave, r = lane & 31, hh = lane >> 5;
    for (int unit = F.vcu; unit < 256; unit += F.G) {
        const int b = unit >> 5, h = unit & 31, qh = h >> 1;
        const float Aexp = __expf(a.in[I_ALOG][h]), dtb = a.in[I_DTB][h];
        const bf16* Qg = CONV + (size_t)(b * 16 + qh) * SEQ * 128; const bf16* Kg = Qg + CONV_K; const bf16* Vg = CONV + CONV_V + (size_t)(b * 32 + h) * SEQ * 128;
        __syncthreads();
        {
            LAS float* Lw = (LAS float*)(F.lds + w * 17920);
            LAS bf16* Sw = (LAS bf16*)(F.lds + w * 17920);
            LAS float* gtab = (LAS float*)(F.lds + w * 17920 + 17408);
            LAS float* btab = gtab + 64;
            float av_n = AB[(size_t)(b * SEQ + w * 64 + lane) * 256 + h], bv_n = AB[(size_t)(b * SEQ + w * 64 + lane) * 256 + 32 + h];
            for (int n = w; n < 32; n += 8) {
                int r = lane & 31, hh = lane >> 5; asm volatile("" : "+v"(r), "+v"(hh));
                const int t0 = b * SEQ + n * 64; const size_t cidx = (size_t)unit * 32 + n;
                bf16x8 kf[2][8], qfa[2][8];
#pragma unroll
                for (int bi = 0; bi < 2; ++bi)
#pragma unroll
                    for (int ks = 0; ks < 8; ++ks) { kf[bi][ks] = *(const bf16x8*)(Kg + (size_t)(n * 64 + 32 * bi + r) * 128 + 16 * ks + 8 * hh); qfa[bi][ks] = *(const bf16x8*)(Qg + (size_t)(n * 64 + 32 * bi + r) * 128 + 16 * ks + 8 * hh); }
                const float av = av_n, bv = bv_n;
                { const int nn = n + 8 < 32 ? n + 8 : n; av_n = AB[(size_t)(b * SEQ + nn * 64 + lane) * 256 + h]; bv_n = AB[(size_t)(b * SEQ + nn * 64 + lane) * 256 + 32 + h]; }
                const float xx = av + dtb, sp = xx > 20.f ? xx : log1pf(__expf(xx));
                const float gl = -Aexp * sp, be = sigmoidf_(bv);
                float gc = gl;
#pragma unroll
                for (int o = 1; o < 64; o <<= 1) { const float y = __shfl_up(gc, o); if (lane >= o) gc += y; }
                const float gc63 = __shfl(gc, 63);
                gtab[lane] = gc; btab[lane] = be; LDS_WAIT();
                SCg[(cidx * 3 + 0) * 64 + lane] = __expf(gc); SCg[(cidx * 3 + 1) * 64 + lane] = be; SCg[(cidx * 3 + 2) * 64 + lane] = __expf(gc63 - gc);
                const float gcol0 = __shfl(gc, r), gcol1 = __shfl(gc, 32 + r);
#pragma unroll
                for (int bi = 0; bi < 2; ++bi) {
                    bf16x8 qf[8];
#pragma unroll
                    for (int ks = 0; ks < 8; ++ks) qf[ks] = qfa[bi][ks];
#pragma unroll
                    for (int bm = 0; bm < 2; ++bm) {
                        f32x16 acc;
#pragma unroll
                        for (int i = 0; i < 16; ++i) acc[i] = 0.f;
                        if (bm <= bi) {
#pragma unroll
                            for (int ks = 0; ks < 8; ++ks) acc = MFMA32(qf[ks], kf[bm][ks], acc);
                        }
                        const float gm = bm ? gcol1 : gcol0; const int m = 32 * bm + r;
#pragma unroll
                        for (int g = 0; g < 4; ++g) { const f32x4 gi = *(const LAS f32x4*)(gtab + 32 * bi + 8 * g + 4 * hh);
#pragma unroll
                            for (int jj = 0; jj < 4; ++jj) { const int i = 32 * bi + 8 * g + 4 * hh + jj;
                                const float v = (i >= m) ? acc[4 * g + jj] * __expf(fminf(gi[jj] - gm, 0.f)) : 0.f;
                                Sw[i * 64 + m] = (bf16)f2bf(v); } }
                    }
                }
                LDS_WAIT();
#pragma unroll
                for (int x = 0; x < 8; ++x) { const int p = lane + 64 * x; *(v4u*)(QKg + cidx * 4096 + p * 8) = *(const LAS v4u*)(Sw + p * 8); }
                LDS_WAIT();
#pragma unroll
                for (int bi = 0; bi < 2; ++bi)
#pragma unroll
                    for (int bj = 0; bj <= bi; ++bj) {
                        f32x16 acc;
#pragma unroll
                        for (int i = 0; i < 16; ++i) acc[i] = 0.f;
#pragma unroll
                        for (int ks = 0; ks < 8; ++ks) acc = MFMA32(kf[bi][ks], kf[bj][ks], acc);
                        const float gj = bj ? gcol1 : gcol0;
#pragma unroll
                        for (int g = 0; g < 4; ++g) { const f32x4 gi = *(const LAS f32x4*)(gtab + 32 * bi + 8 * g + 4 * hh), bi4 = *(const LAS f32x4*)(btab + 32 * bi + 8 * g + 4 * hh);
#pragma unroll
                            for (int jj = 0; jj < 4; ++jj) { const int i = 32 * bi + 8 * g + 4 * hh + jj;
                                Lw[i * 68 + 32 * bj + r] = acc[4 * g + jj] * bi4[jj] * __expf(fminf(gi[jj] - gj, 0.f)); } }
                    }
                LDS_WAIT();
                f32x2 Tc2[32];
                int lv = lane; asm volatile("" : "+v"(lv));
                f32x4 rowA[16], rowB[16];
#define D1_LOADROW(dst, i_) do { _Pragma("unroll") for (int j4 = 0; j4 < ((i_) + 3) / 4; ++j4) dst[j4] = *(const LAS f32x4*)(Lw + (i_) * 68 + 4 * j4); } while (0)
#define D1_ROW(src, i_) do { f32x2 sA = (f32x2){((i_) == lv) ? 1.f : 0.f, 0.f}, sB = (f32x2){0.f, 0.f}, sC = (f32x2){0.f, 0.f}, sD = (f32x2){0.f, 0.f}; \
                    _Pragma("unroll") for (int j4 = 0; j4 < ((i_) + 3) / 4; ++j4) { if (j4 & 1) { sC -= (f32x2){src[j4][0], src[j4][1]} * Tc2[2 * j4]; sD -= (f32x2){src[j4][2], src[j4][3]} * Tc2[2 * j4 + 1]; } \
                                                                                       else { sA -= (f32x2){src[j4][0], src[j4][1]} * Tc2[2 * j4]; sB -= (f32x2){src[j4][2], src[j4][3]} * Tc2[2 * j4 + 1]; } } \
                    const f32x2 sS = (sA + sC) + (sB + sD); const float tv_ = sS.x + sS.y; if ((i_) & 1) Tc2[(i_) >> 1].y = tv_; else Tc2[(i_) >> 1].x = tv_; } while (0)
                constexpr int D1_PF = 44;
#define D1_ZERO(i_) do { if (((i_) & 3) == 0) { Tc2[(i_) >> 1] = (f32x2){0.f, 0.f}; Tc2[((i_) >> 1) + 1] = (f32x2){0.f, 0.f}; } } while (0)
                D1_LOADROW(rowA, 0);
#pragma unroll
                for (int ip = 0; ip < D1_PF / 2; ++ip) { const int i = 2 * ip;
                    D1_ZERO(i);     D1_LOADROW(rowB, i + 1); pg8::wait_l_n((i + 4) / 4); D1_ROW(rowA, i);     asm volatile("" ::: "memory");
                    D1_ZERO(i + 1); D1_LOADROW(rowA, i + 2); pg8::wait_l_n((i + 5) / 4); D1_ROW(rowB, i + 1); asm volatile("" ::: "memory");
                }
                D1_ZERO(D1_PF); asm volatile("s_waitcnt lgkmcnt(0)" ::: "memory"); D1_ROW(rowA, D1_PF); asm volatile("" ::: "memory");
#pragma unroll
                for (int i = D1_PF + 1; i < 64; ++i) {
                    D1_ZERO(i); D1_LOADROW(rowA, i); asm volatile("s_waitcnt lgkmcnt(0)" ::: "memory");
                    D1_ROW(rowA, i); asm volatile("" ::: "memory");
                }
#undef D1_ZERO
#undef D1_LOADROW
#undef D1_ROW
                LDS_WAIT();
#pragma unroll
                for (int i = 0; i < 64; ++i) Sw[i * 64 + lane] = (bf16)f2bf((i & 1) ? Tc2[i >> 1].y : Tc2[i >> 1].x);
                LDS_WAIT();
#pragma unroll
                for (int x = 0; x < 8; ++x) { const int p = lane + 64 * x; *(v4u*)(Tg + cidx * 4096 + p * 8) = *(const LAS v4u*)(Sw + p * 8); }
                LDS_WAIT();
            }
        }
    }
    VM_WAIT();
    __syncthreads();
    for (int unit = F.vcu; unit < 256; unit += F.G) {
        const int b = unit >> 5, h = unit & 31, qh = h >> 1;
        const bf16* Qg = CONV + (size_t)(b * 16 + qh) * SEQ * 128; const bf16* Kg = Qg + CONV_K; const bf16* Vg = CONV + CONV_V + (size_t)(b * 32 + h) * SEQ * 128;
        __syncthreads();
        LAS bf16* Kn = (LAS bf16*)(F.lds + D2_KN); LAS bf16* Qn = (LAS bf16*)(F.lds + D2_QN); LAS bf16* Vn = (LAS bf16*)(F.lds + D2_VN); LAS bf16* Kd = (LAS bf16*)(F.lds + D2_KD);
        LAS bf16* Tm = (LAS bf16*)(F.lds + D2_TM); LAS bf16* QKm = (LAS bf16*)(F.lds + D2_QKM);
        LAS float* sa = (LAS float*)(F.lds + D2_SC); LAS float* sb = sa + 64; LAS float* ssp = sb + 64; LAS float* owl = ssp + 512;
        LAS bf16* STw = (LAS bf16*)(F.lds + D2_PRIV + w * D2_PW); LAS bf16* RTw = STw + 16 * 136; LAS bf16* VnTw = RTw + 16 * 72;
        LAS bf16* SQw = RTw;
        const int c = lane & 15, q = lane >> 4, E0 = 16 * w;
        for (int i = lane; i < 16 * 136 / 8; i += 64) *(LAS v4u*)(STw + i * 8) = (v4u){0u, 0u, 0u, 0u};
        f32x4 sacc[8];
#pragma unroll
        for (int x = 0; x < 8; ++x) sacc[x] = (f32x4){0.f, 0.f, 0.f, 0.f};
        v4u pK[2], pQ[2], pV[2], pT, pQK; float psc[2], psa = 0.f, psb = 0.f; v4u pz[2];
        const int prow = tid >> 4, pcol = (tid & 15) * 8;
        if (tid < 128) owl[tid] = a.in[I_ONW][tid];
        f32x2 oww[8];
#pragma unroll
        for (int x = 0; x < 8; ++x) oww[x] = *(const f32x2*)(a.in[I_ONW] + E0 + 2 * x);
#define D2_PREFETCH(n_) do { const int t0_ = b * SEQ + (n_) * 64; const size_t ci_ = (size_t)unit * 32 + (n_); \
            _Pragma("unroll") for (int x = 0; x < 2; ++x) { const size_t ro_ = (size_t)((n_) * 64 + prow + 32 * x) * 128 + pcol; pK[x] = *(const v4u*)(Kg + ro_); pQ[x] = *(const v4u*)(Qg + ro_); pV[x] = *(const v4u*)(Vg + ro_); \
                psc[x] = SCg[(ci_ * 3 + 2) * 64 + prow + 32 * x]; } \
            pT = *(const v4u*)(Tg + ci_ * 4096 + tid * 8); pQK = *(const v4u*)(QKg + ci_ * 4096 + tid * 8); \
            if (tid < 64) { psa = SCg[(ci_ * 3 + 0) * 64 + tid]; psb = SCg[(ci_ * 3 + 1) * 64 + tid]; } } while (0)
#define D2_ZPREFETCH(n_) do { const bf16* zp_ = PROJ + (size_t)(b * SEQ + (n_) * 64 + lane) * NPROJ + PC_Z + h * 128 + E0; pz[0] = *(const v4u*)zp_; pz[1] = *(const v4u*)(zp_ + 8); } while (0)
#define MFMA16(a_, b_, c_) __builtin_amdgcn_mfma_f32_16x16x32_bf16((a_), (b_), (c_), 0, 0, 0)
        D2_PREFETCH(0);
        asm volatile("" : "+v"(pK[0]), "+v"(pK[1]), "+v"(pQ[0]), "+v"(pQ[1]), "+v"(pV[0]), "+v"(pV[1]), "+v"(pT), "+v"(pQK));
        asm volatile("" : "+v"(psc[0]), "+v"(psc[1]), "+v"(psa), "+v"(psb));
        D2_ZPREFETCH(0);
        for (int n = 0; n < 32; ++n) {
            const int t0 = b * SEQ + n * 64;
            asm volatile("" : "+v"(pK[0]), "+v"(pK[1]), "+v"(pQ[0]), "+v"(pQ[1]), "+v"(pV[0]), "+v"(pV[1]), "+v"(pT), "+v"(pQK));
            asm volatile("" : "+v"(psc[0]), "+v"(psc[1]), "+v"(psa), "+v"(psb));
#pragma unroll
            for (int x = 0; x < 2; ++x) { const int row = prow + 32 * x;
                *(LAS v4u*)(Kn + row * 136 + pcol) = pK[x]; *(LAS v4u*)(Qn + row * 136 + pcol) = pQ[x]; *(LAS v4u*)(Vn + row * 136 + pcol) = pV[x];
                const float cs = psc[x]; v4u kd;
                kd.x = pk2(bflo(pK[x].x) * cs, bfhi(pK[x].x) * cs); kd.y = pk2(bflo(pK[x].y) * cs, bfhi(pK[x].y) * cs); kd.z = pk2(bflo(pK[x].z) * cs, bfhi(pK[x].z) * cs); kd.w = pk2(bflo(pK[x].w) * cs, bfhi(pK[x].w) * cs);
                *(LAS v4u*)(Kd + row * 136 + pcol) = kd; }
            *(LAS v4u*)(Tm + (tid >> 3) * 72 + (tid & 7) * 8) = pT; *(LAS v4u*)(QKm + (tid >> 3) * 72 + (tid & 7) * 8) = pQK;
            if (tid < 64) { sa[tid] = psa; sb[tid] = psb; }
            LDS_WAIT(); __builtin_amdgcn_s_barrier(); asm volatile("" ::: "memory");
            const float dc = sa[63];
            { const int nn = n + 1 < 32 ? n + 1 : 31; D2_PREFETCH(nn); }
            f32x4 aks[4], aqs[4]; f32x2 gz[8];
#pragma unroll
            for (int rb = 0; rb < 4; ++rb) { aks[rb] = (f32x4){0.f, 0.f, 0.f, 0.f}; aqs[rb] = (f32x4){0.f, 0.f, 0.f, 0.f}; }
#pragma unroll
            for (int kh = 0; kh < 2; ++kh) {
                bf16x8 bfr[2], kfr[2][4], qfr[2][4];
#pragma unroll
                for (int k2 = 0; k2 < 2; ++k2) { const int ks = 2 * kh + k2; bfr[k2] = ldfrag(STw + c * 136 + 32 * ks + 8 * q);
#pragma unroll
                    for (int rb = 0; rb < 4; ++rb) { kfr[k2][rb] = ldfrag(Kn + (16 * rb + c) * 136 + 32 * ks + 8 * q); qfr[k2][rb] = ldfrag(Qn + (16 * rb + c) * 136 + 32 * ks + 8 * q); } }
                __builtin_amdgcn_sched_barrier(0);
                if (kh == 0) {
                    asm volatile("" : "+v"(pz[0]), "+v"(pz[1]));
#pragma unroll
                    for (int x = 0; x < 8; ++x) { const unsigned zu = x < 4 ? pz[0][x] : pz[1][x - 4]; const float z0 = bflo(zu), z1 = bfhi(zu);
                        gz[x] = (f32x2){oww[x].x * (z0 * sigmoidf_(z0)), oww[x].y * (z1 * sigmoidf_(z1))}; }
                    __builtin_amdgcn_sched_barrier(0);
                }
#pragma unroll
                for (int k2 = 0; k2 < 2; ++k2)
#pragma unroll
                    for (int rb = 0; rb < 4; ++rb) { aks[rb] = MFMA16(kfr[k2][rb], bfr[k2], aks[rb]); aqs[rb] = MFMA16(qfr[k2][rb], bfr[k2], aqs[rb]); }
                __builtin_amdgcn_sched_barrier(0);
            }
            { f32x4 a4[4], b4[4]; unsigned short vv[16];
#pragma unroll
              for (int rb = 0; rb < 4; ++rb) { const int i0 = 16 * rb + 4 * q; a4[rb] = *(const LAS f32x4*)(sa + i0); b4[rb] = *(const LAS f32x4*)(sb + i0);
#pragma unroll
                for (int j = 0; j < 4; ++j) vv[4 * rb + j] = Vn[(i0 + j) * 136 + E0 + c]; }
              __builtin_amdgcn_sched_barrier(0);
#pragma unroll
              for (int rb = 0; rb < 4; ++rb) { const int i0 = 16 * rb + 4 * q; float rv[4];
#pragma unroll
                for (int j = 0; j < 4; ++j) { rv[j] = b4[rb][j] * (bflo((unsigned)vv[4 * rb + j]) - a4[rb][j] * aks[rb][j]); aqs[rb][j] *= a4[rb][j]; }
                v2u pk; pk.x = pk2(rv[0], rv[1]); pk.y = pk2(rv[2], rv[3]); *(LAS v2u*)(RTw + c * 72 + i0) = pk; } }
            LDS_WAIT();
            { bf16x8 tfr[4][2], rfr[2]; f32x4 va[4];
#pragma unroll
              for (int ks = 0; ks < 2; ++ks) { rfr[ks] = ldfrag(RTw + c * 72 + 32 * ks + 8 * q);
#pragma unroll
                for (int rb = 0; rb < 4; ++rb) if (ks == 0 || rb >= 2) tfr[rb][ks] = ldfrag(Tm + (16 * rb + c) * 72 + 32 * ks + 8 * q); }
              __builtin_amdgcn_sched_barrier(0);
#pragma unroll
              for (int rb = 0; rb < 4; ++rb) { va[rb] = (f32x4){0.f, 0.f, 0.f, 0.f};
#pragma unroll
                for (int ks = 0; ks < 2; ++ks) if (ks == 0 || rb >= 2) va[rb] = MFMA16(tfr[rb][ks], rfr[ks], va[rb]); }
#pragma unroll
              for (int rb = 0; rb < 4; ++rb) { v2u pk; pk.x = pk2(va[rb][0], va[rb][1]); pk.y = pk2(va[rb][2], va[rb][3]); *(LAS v2u*)(VnTw + c * 72 + 16 * rb + 4 * q) = pk; } }
            LDS_WAIT();
            bf16x8 vfr[2];
            { bf16x8 qkf[4][2];
#pragma unroll
              for (int ks = 0; ks < 2; ++ks) { vfr[ks] = ldfrag(VnTw + c * 72 + 32 * ks + 8 * q);
#pragma unroll
                for (int rb = 0; rb < 4; ++rb) if (ks == 0 || rb >= 2) qkf[rb][ks] = ldfrag(QKm + (16 * rb + c) * 72 + 32 * ks + 8 * q); }
              __builtin_amdgcn_sched_barrier(0);
#pragma unroll
              for (int rb = 0; rb < 4; ++rb) {
#pragma unroll
                for (int ks = 0; ks < 2; ++ks) if (ks == 0 || rb >= 2) aqs[rb] = MFMA16(qkf[rb][ks], vfr[ks], aqs[rb]); }
#pragma unroll
              for (int rb = 0; rb < 4; ++rb)
#pragma unroll
                for (int j = 0; j < 4; ++j) SQw[(16 * rb + 4 * q + j) * 18 + c] = (bf16)f2bf(aqs[rb][j]); }
            LDS_WAIT();
            unsigned orow[8];
            { float ssum = 0.f;
#pragma unroll
              for (int x = 0; x < 8; ++x) { orow[x] = *(const LAS unsigned*)(SQw + lane * 18 + 2 * x); ssum += bflo(orow[x]) * bflo(orow[x]) + bfhi(orow[x]) * bfhi(orow[x]); }
              ssp[w * 64 + lane] = ssum; }
            { const int tq = (lane & 15) >> 2, tp = lane & 3;
#pragma unroll
              for (int dh = 0; dh < 2; ++dh) { bf16x8 kfrT[4][2];
#pragma unroll
                for (int d4 = 0; d4 < 4; ++d4)
#pragma unroll
                  for (int ks = 0; ks < 2; ++ks) { const LAS bf16* kp = Kd + (32 * ks + 8 * q + tq) * 136 + 16 * (4 * dh + d4) + 4 * tp; kfrT[d4][ks] = trfrag(kp, kp + 4 * 136); }
                __builtin_amdgcn_sched_barrier(0);
#pragma unroll
                for (int d4 = 0; d4 < 4; ++d4) { const int db = 4 * dh + d4; sacc[db] *= dc;
#pragma unroll
                  for (int ks = 0; ks < 2; ++ks) sacc[db] = MFMA16(kfrT[d4][ks], vfr[ks], sacc[db]); }
#pragma unroll
                for (int d4 = 0; d4 < 4; ++d4) { const int db = 4 * dh + d4; v2u pk; pk.x = pk2(sacc[db][0], sacc[db][1]); pk.y = pk2(sacc[db][2], sacc[db][3]); *(LAS v2u*)(STw + c * 136 + 16 * db + 4 * q) = pk; }
                __builtin_amdgcn_sched_barrier(0); } }
            LDS_WAIT(); __builtin_amdgcn_s_barrier(); asm volatile("" ::: "memory");
            asm volatile("" : "+v"(pK[0]), "+v"(pK[1]), "+v"(pQ[0]), "+v"(pQ[1]), "+v"(pV[0]), "+v"(pV[1]), "+v"(pT), "+v"(pQK));
            asm volatile("" : "+v"(psc[0]), "+v"(psc[1]), "+v"(psa), "+v"(psb));
            { float tt = 0.f;
#pragma unroll
              for (int ww = 0; ww < 8; ++ww) tt += ssp[ww * 64 + lane];
              const float rstd = __frsqrt_rn(tt * (1.f / 128.f) + RMS_EPS);
              unsigned ov[8];
#pragma unroll
              for (int x = 0; x < 8; ++x) ov[x] = pk2(bflo(orow[x]) * rstd * gz[x].x, bfhi(orow[x]) * rstd * gz[x].y);
              bf16* op = OCAT + (size_t)(t0 + lane) * KCAT + h * 128 + E0;
              *(v4u*)op = (v4u){ov[0], ov[1], ov[2], ov[3]}; *(v4u*)(op + 8) = (v4u){ov[4], ov[5], ov[6], ov[7]}; }
            { const int nn = n + 1 < 32 ? n + 1 : 31; D2_ZPREFETCH(nn); }
        }
        __syncthreads();
#undef MFMA16
#undef D2_ZPREFETCH
#undef D2_PREFETCH
    }
}

__device__ __forceinline__ void p6_router(Frame& F, const Args& a) {
    const bf16* X1 = (const bf16*)(F.ws + WS_X1); const float* RWT = (const float*)(F.ws + WS_ROUTE + RT_RWT); const float* RB = a.in[I_RB];
    int* tok_e = (int*)(F.ws + WS_ROUTE + RT_E); int* tok_slot = (int*)(F.ws + WS_ROUTE + RT_SLOT); float* tok_gate = (float*)(F.ws + WS_ROUTE + RT_GATE); float* rstdp = (float*)(F.ws + WS_ROUTE + RT_RSTD);
    LAS float* part = (LAS float*)(F.lds);
    LAS float* ssq = (LAS float*)(F.lds + 8 * 32 * 33 * 4);
    LAS float* lg = ssq + 256;
    LAS float* sst = lg + 32 * 33;
    const int lane = F.lane, w = F.wave, r = lane & 31, hh = lane >> 5;
    unsigned char* XQ = (unsigned char*)(F.ws + WS_XBUF); int* tokmap = (int*)(F.ws + WS_TOKMAP); const float* N2 = a.in[I_N2W];
    bf16x8 wh[16], wl[16];
    { const bf16* whr = (const bf16*)RWT + (size_t)r * D + 256 * w + 8 * hh; const bf16* wlr = whr + (size_t)NE * D;
#pragma unroll
      for (int j = 0; j < 16; ++j) { wh[j] = *(const bf16x8*)(whr + 16 * j); wl[j] = *(const bf16x8*)(wlr + 16 * j); } }
    for (int tile = F.vcu; tile < T / 32; tile += F.G) {
        const int t0 = tile * 32;
        f32x16 acc;
#pragma unroll
        for (int i = 0; i < 16; ++i) acc[i] = 0.f;
        float ss = 0.f;
        const bf16* xrow = X1 + (size_t)(t0 + r) * D + 256 * w + 8 * hh;
        {
            bf16x8 xa[16];
#pragma unroll
            for (int j = 0; j < 16; ++j) xa[j] = *(const bf16x8*)(xrow + 16 * j);
#pragma unroll
            for (int j = 0; j < 16; ++j) { const v4u xu = __builtin_bit_cast(v4u, xa[j]);
#pragma unroll
                for (int q = 0; q < 4; ++q) { const float x0 = bflo(xu[q]), x1v = bfhi(xu[q]); ss += x0 * x0 + x1v * x1v; }
                acc = MFMA32(xa[j], wh[j], acc); acc = MFMA32(xa[j], wl[j], acc); }
        }
        ss += __shfl_xor(ss, 32);
        __syncthreads();
#pragma unroll
        for (int g = 0; g < 4; ++g)
#pragma unroll
            for (int jj = 0; jj < 4; ++jj) part[(w * 32 + 8 * g + 4 * hh + jj) * 33 + r] = acc[4 * g + jj];
        if (hh == 0) ssq[w * 32 + r] = ss;
        __syncthreads();
        for (int idx = F.tid; idx < 1024; idx += 512) { const int tk = idx >> 5, ee = idx & 31; float s = 0.f;
#pragma unroll
            for (int ww = 0; ww < 8; ++ww) s += part[(ww * 32 + tk) * 33 + ee];
            lg[tk * 33 + ee] = s; }
        if (F.tid < 32) { float s = 0.f;
#pragma unroll
            for (int ww = 0; ww < 8; ++ww) s += ssq[ww * 32 + F.tid];
            sst[F.tid] = s; }
        __syncthreads();
        if (w == 0) {
            const int tk = lane & 31; const bool valid = lane < 32;
            const float rstd = __frsqrt_rn(sst[tk] * (1.f / D) + RMS_EPS);
            float v[32];
#pragma unroll
            for (int ee = 0; ee < 32; ++ee) v[ee] = lg[tk * 33 + ee] * rstd + RB[ee];
            unsigned taken = 0u; float tv[4]; int te[4];
#pragma unroll
            for (int k = 0; k < 4; ++k) { float best = -3.0e38f; int bi = 0;
#pragma unroll
                for (int ee = 0; ee < 32; ++ee) { const bool ok = !((taken >> ee) & 1u) && (v[ee] > best); best = ok ? v[ee] : best; bi = ok ? ee : bi; }
                tv[k] = best; te[k] = bi; taken |= 1u << bi; }
            const float e1 = __expf(tv[1] - tv[0]), e2 = __expf(tv[2] - tv[0]), e3 = __expf(tv[3] - tv[0]);
            const float inv = 1.0f / (1.0f + e1 + e2 + e3);
            const float gt[4] = {inv, e1 * inv, e2 * inv, e3 * inv};
            unsigned mycnt = 0u; int rk[4] = {0, 0, 0, 0};
            const unsigned long long ltmask = (1ull << lane) - 1ull;
#pragma unroll
            for (int ee = 0; ee < 32; ++ee) {
                const bool has = valid && ((taken >> ee) & 1u);
                const unsigned long long bal = __ballot(has);
                const unsigned c = (unsigned)__popcll(bal), rnk = (unsigned)__popcll(bal & ltmask);
                mycnt = (lane == ee) ? c : mycnt;
#pragma unroll
                for (int k = 0; k < 4; ++k) rk[k] = (te[k] == ee) ? (int)rnk : rk[k];
            }
            unsigned base = 0u;
            if (valid && mycnt > 0u) base = atomicAdd(F.ctl + CW_CNT + 64 * lane, mycnt);
#pragma unroll
            for (int k = 0; k < 4; ++k) { const int bs = __shfl((int)base, te[k]); rk[k] += bs; }
            if (valid) {
                *(int4*)(tok_e + (size_t)(t0 + tk) * 4) = make_int4(te[0], te[1], te[2], te[3]);
                *(int4*)(tok_slot + (size_t)(t0 + tk) * 4) = make_int4(rk[0], rk[1], rk[2], rk[3]);
                *(float4*)(tok_gate + (size_t)(t0 + tk) * 4) = make_float4(gt[0], gt[1], gt[2], gt[3]);
                rstdp[t0 + tk] = rstd;
#pragma unroll
                for (int k = 0; k < 4; ++k) tokmap[(size_t)te[k] * T + rk[k]] = t0 + tk;
            }
        } else {
            f32x4 wv2[8];
#pragma unroll
            for (int j = 0; j < 8; ++j) wv2[j] = *(const f32x4*)(N2 + 4 * lane + 256 * j);
            for (int tk = w - 1; tk < 32; tk += 7) {
                const float rstd = __frsqrt_rn(sst[tk] * (1.f / D) + RMS_EPS) * F8_SX; const int m = t0 + tk;
                const v2u* xp = (const v2u*)(X1 + (size_t)m * D) + lane; unsigned* o0 = (unsigned*)(XQ + (size_t)m * D) + lane; v2u xv[8];
#pragma unroll
                for (int j = 0; j < 8; ++j) xv[j] = xp[64 * j];
#pragma unroll
                for (int j = 0; j < 8; ++j) { const f32x4 y = (f32x4){bflo(xv[j].x), bfhi(xv[j].x), bflo(xv[j].y), bfhi(xv[j].y)} * rstd * wv2[j]; o0[64 * j] = pk4_f8(y.x, y.y, y.z, y.w); }
            }
        }
    }
}

__device__ __forceinline__ int moe_tables(Frame& F, LAS int* tile_e, LAS int* tbase, LAS int* rowoff) {
    __syncthreads();
    if (F.wave == 0) {
        const int ee = F.lane & 31;
        const unsigned cnt = __hip_atomic_load(F.ctl + CW_CNT + 64 * ee, __ATOMIC_RELAXED, __HIP_MEMORY_SCOPE_AGENT);
        const int nt = (int)((cnt + 255u) >> 8);
        int incl = nt;
#pragma unroll
        for (int o = 1; o < 32; o <<= 1) { const int y = __shfl_up(incl, o, 32); if ((F.lane & 31) >= o) incl += y; }
        const int excl = incl - nt;
        if (F.lane < 32) { rowoff[ee] = excl * 256; for (int i = 0; i < nt; ++i) { tile_e[excl + i] = ee; tbase[excl + i] = ee * T + i * 256; } if (ee == 31) rowoff[32] = incl; }
    }
    __syncthreads();
    return rowoff[32];
}

__device__ __forceinline__ float wave_sum_x(float v) {
    v += dppf<0xB1>(v); v += dppf<0x4E>(v); v += dppf<0x141>(v); v += dppf<0x140>(v);
    { const unsigned u = __builtin_bit_cast(unsigned, v); const auto r = __builtin_amdgcn_permlane16_swap(u, u, false, false); const unsigned r0 = r[0], r1 = r[1]; v = __builtin_bit_cast(float, r0) + __builtin_bit_cast(float, r1); }
    { const unsigned u = __builtin_bit_cast(unsigned, v); const auto r = __builtin_amdgcn_permlane32_swap(u, u, false, false); const unsigned r0 = r[0], r1 = r[1]; v = __builtin_bit_cast(float, r0) + __builtin_bit_cast(float, r1); }
    return v;
}
__device__ __forceinline__ void p10_final(Frame& F, const Args& a) {
    const bf16* X1 = (const bf16*)(F.ws + WS_X1); const unsigned char* Y = (const unsigned char*)(F.ws + WS_Y); const float* NF = a.in[I_NFW];
    const int* tok_e = (const int*)(F.ws + WS_ROUTE + RT_E); const int* tok_slot = (const int*)(F.ws + WS_ROUTE + RT_SLOT); const float* tok_gate = (const float*)(F.ws + WS_ROUTE + RT_GATE);
    LAS int* rowoff = (LAS int*)(F.lds + pg8::STAGE_BYTES + 6656);
    (void)moe_tables(F, (LAS int*)(F.lds + pg8::STAGE_BYTES + 4096), (LAS int*)(F.lds + pg8::STAGE_BYTES + 5376), rowoff);
    const int gw = F.vcu * 8 + F.wave, NGW = F.G * 8, lane = F.lane;
    f32x4 wv[8];
#pragma unroll
    for (int j = 0; j < 8; ++j) wv[j] = *(const f32x4*)(NF + 4 * lane + 256 * j);
    for (int base = gw; base < T; base += 4 * NGW) {
        int4 te[4], sl[4]; float4 gg[4]; int4 rr[4];
#pragma unroll
        for (int k = 0; k < 4; ++k) { const int mc = base + k * NGW < T ? base + k * NGW : T - 1; te[k] = *(const int4*)(tok_e + (size_t)mc * 4); sl[k] = *(const int4*)(tok_slot + (size_t)mc * 4); gg[k] = *(const float4*)(tok_gate + (size_t)mc * 4); }
#pragma unroll
        for (int k = 0; k < 4; ++k) rr[k] = make_int4(rowoff[te[k].x] + sl[k].x, rowoff[te[k].y] + sl[k].y, rowoff[te[k].z] + sl[k].z, rowoff[te[k].w] + sl[k].w);
        v2u xb[2][8]; unsigned yb[2][4][8];
#define P10_LOAD(k_, b_) { const int mc_ = base + (k_) * NGW < T ? base + (k_) * NGW : T - 1; const v2u* xr_ = (const v2u*)(X1 + (size_t)mc_ * D) + lane; \
            const unsigned* y0_ = (const unsigned*)(Y + (size_t)rr[k_].x * D) + lane; const unsigned* y1_ = (const unsigned*)(Y + (size_t)rr[k_].y * D) + lane; \
            const unsigned* y2_ = (const unsigned*)(Y + (size_t)rr[k_].z * D) + lane; const unsigned* y3_ = (const unsigned*)(Y + (size_t)rr[k_].w * D) + lane; \
            _Pragma("unroll") for (int j = 0; j < 8; ++j) { xb[b_][j] = xr_[64 * j]; yb[b_][0][j] = y0_[64 * j]; yb[b_][1][j] = y1_[64 * j]; yb[b_][2][j] = y2_[64 * j]; yb[b_][3][j] = y3_[64 * j]; } }
        P10_LOAD(0, 0);
#pragma unroll
        for (int k = 0; k < 4; ++k) {
            const int cb = k & 1;
            if (k + 1 < 4) P10_LOAD(k + 1, cb ^ 1);
            const int m = base + k * NGW;
            const float g0 = gg[k].x * (1.f / F8_SY), g1 = gg[k].y * (1.f / F8_SY), g2 = gg[k].z * (1.f / F8_SY), g3 = gg[k].w * (1.f / F8_SY);
            f32x4 v[8]; float ssq = 0.f;
#pragma unroll
            for (int j = 0; j < 8; ++j) {
                const v2u xv = xb[cb][j]; f32x4 acc = (f32x4){bflo(xv.x), bfhi(xv.x), bflo(xv.y), bfhi(xv.y)};
                acc += f8x4(yb[cb][0][j]) * g0; acc += f8x4(yb[cb][1][j]) * g1; acc += f8x4(yb[cb][2][j]) * g2; acc += f8x4(yb[cb][3][j]) * g3;
                v[j] = acc; ssq += (acc.x * acc.x + acc.y * acc.y) + (acc.z * acc.z + acc.w * acc.w);
            }
            const float rstd = __frsqrt_rn(wave_sum_x(ssq) * (1.f / D) + RMS_EPS);
            if (m < T) { f32x4* o = (f32x4*)(a.out + (size_t)m * D) + lane;
#pragma unroll
                for (int j = 0; j < 8; ++j) o[64 * j] = v[j] * rstd * wv[j]; }
        }
#undef P10_LOAD
    }
}

constexpr int NPHASE = 11;
__global__ void __launch_bounds__(512, 2) fwd(Args args) {
    extern __shared__ __attribute__((aligned(16))) unsigned char lds[];
    Frame F;
    F.lds = (LAS unsigned char*)lds; F.ws = args.ws; F.ctl = (unsigned*)(args.ws + WS_CTL);
    F.tid = threadIdx.x; F.lane = F.tid & 63; F.wave = __builtin_amdgcn_readfirstlane(F.tid >> 6);
    F.G = gridDim.x; { const int bx = blockIdx.x; F.vcu = (F.G % 8 == 0) ? (bx % 8) * (F.G / 8) + bx / 8 : bx; }
    volatile LAS unsigned* MISC = (volatile LAS unsigned*)(F.lds + MISC_OFF);
    if (F.tid < 64) MISC[F.tid] = 0u;
    __syncthreads();
    const int lo = args.ph_lo, hi = args.ph_hi;
    XcdBarrier bar; bar.bar = F.ctl + CW_BAR; bar.x = 0; bar.st = nullptr;
    if (hi - lo > 1) bar = xcd_barrier_post(F.ctl + CW_BAR, MISC + 8);
#define IN(k) (lo <= (k) && (k) < hi)
#define SEAM(k) do { if (IN(k) && IN((k) + 1)) xcd_barrier(bar); } while (0)
    unsigned char* ws = args.ws;
    LAS int* tile_e = (LAS int*)(F.lds + pg8::STAGE_BYTES + 4096);
    LAS int* tbase = (LAS int*)(F.lds + pg8::STAGE_BYTES + 5376); LAS int* rowoff = (LAS int*)(F.lds + pg8::STAGE_BYTES + 6656);

    if (IN(0)) { p0_prologue(F, args); SEAM(0); }
    if (IN(1)) {
        pg8::EpiProj E{(bf16*)(ws + WS_PROJ), (float*)(ws + WS_AB)};
        if (F.G == 256) {
            const int xcd = (int)blockIdx.x & 7, j = (int)blockIdx.x >> 3;
            if (j >= 24) { p_convert_experts(F, args, ((j - 24) * 8 + xcd) * 8 + F.wave, 64 * 8); __syncthreads(); }
            pg8::SchedP1 S{xcd, j, (const char*)(ws + WS_XN), (const char*)(ws + WS_WIN), (size_t)256 * LDX * 2, (size_t)256 * LDX * 2};
            pg8::gemm_phase<pg8::EpiProj, pg8::SchedP1, true, true>(F.lds, LDX, LDX, S, E);
        } else {
            pg8::Sched<0> S; S.init(T / 256, NWIN_T / 256, F.G, (int)blockIdx.x, D / 64); S.A = (const char*)(ws + WS_XN); S.B = (const char*)(ws + WS_WIN); S.tA = (size_t)256 * LDX * 2; S.tB = (size_t)256 * LDX * 2; S.tile_e = nullptr; S.estride = 0;
            pg8::gemm_phase<pg8::EpiProj, pg8::Sched<0>, true, true>(F.lds, LDX, LDX, S, E);
        }
        SEAM(1);
    }
    if (IN(2)) { p2_prep(F, args); SEAM(2); }
    if (IN(3)) {
        p3_delta(F, args);
        __syncthreads();
        pg8::Sched<1> S; S.init(D / 256, D / 256, F.G, (int)blockIdx.x, 512 / 64); S.A = (const char*)(ws + WS_WCAT) + 8192; S.B = (const char*)(ws + WS_WPOOL); S.tA = (size_t)256 * KCAT * 2; S.tB = (size_t)256 * 512 * 2; S.tile_e = nullptr; S.estride = 0;
        pg8::EpiFold E{(bf16*)(ws + WS_MIXED)};
        pg8::gemm_phase<pg8::EpiFold, pg8::Sched<1>, true, true>(F.lds, KCAT, 512, S, E);
        SEAM(3);
    }
    if (IN(4)) {
        pg8::Sched<3> S; S.init(T / 256, D / 256, F.G, (int)blockIdx.x, 0); S.A = (const char*)(ws + WS_OCAT); S.B = (const char*)(ws + WS_WCAT); S.tA = (size_t)256 * KCAT * 2; S.tB = (size_t)256 * KCAT * 2; S.tile_e = nullptr; S.estride = 0; S.bdelta1 = WS_MIXED - WS_WCAT;
        pg8::EpiBranch E{(bf16*)(ws + WS_H), (const bf16*)(ws + WS_PROJ), args.in[I_BGATE]};
        pg8::gemm_phase<pg8::EpiBranch, pg8::Sched<3>, true, true>(F.lds, KCAT, KCAT, S, E);
        SEAM(4);
    }
    if (IN(5)) {
        pg8::Sched<0> S; S.init(T / 256, D / 256, F.G, (int)blockIdx.x, D / 64); S.A = (const char*)(ws + WS_H); S.B = (const char*)(ws + WS_WOUT); S.tA = (size_t)256 * D * 2; S.tB = (size_t)256 * D * 2; S.tile_e = nullptr; S.estride = 0;
        pg8::EpiOut E{args.in[I_X], (bf16*)(ws + WS_X1)};
        pg8::gemm_phase<pg8::EpiOut, pg8::Sched<0>, true, true>(F.lds, D, D, S, E);
        SEAM(5);
    }
    if (IN(6)) { p6_router(F, args); SEAM(6); }
    if (IN(8)) {
        const int ntiles = moe_tables(F, tile_e, tbase, rowoff);
        pg8::Sched<4> S; S.init(ntiles, (2 * DE) / 256, F.G, (int)blockIdx.x, D / 128); S.A = (const char*)(ws + WS_XBUF); S.B = (const char*)(ws + WS_W1); S.tA = (size_t)256 * D; S.tB = (size_t)256 * D; S.tile_e = tile_e; S.estride = (size_t)2 * DE * D;
        S.rowtok = (const int*)(ws + WS_TOKMAP); S.tbase = tbase; S.tokmax = (unsigned)(T - 1);
        pg8::EpiSwiglu E{(unsigned char*)(ws + WS_ACT), args.in[I_B1], tile_e};
        pg8::gemm_phase<pg8::EpiSwiglu, pg8::Sched<4>, true, true, true>(F.lds, D / 2, D / 2, S, E);
        SEAM(8);
    }
    if (IN(9)) {
        const int ntiles = moe_tables(F, tile_e, tbase, rowoff);
        pg8::Sched<2> S; S.init(ntiles, D / 256, F.G, (int)blockIdx.x, DE / 128); S.A = (const char*)(ws + WS_ACT); S.B = (const char*)(ws + WS_W2); S.tA = (size_t)256 * DE; S.tB = (size_t)256 * DE; S.tile_e = tile_e; S.estride = (size_t)D * DE;
        pg8::EpiY E{(unsigned char*)(ws + WS_Y), args.in[I_B2], tile_e};
        pg8::gemm_phase<pg8::EpiY, pg8::Sched<2>, true, true, true>(F.lds, DE / 2, DE / 2, S, E);
        SEAM(9);
    }
    if (IN(10)) { p10_final(F, args); }
#undef IN
#undef SEAM
}

extern "C" void kernel_launch(void* const* d_in, const int* in_sizes, int n_in, void* d_out, int out_size, void* d_ws, size_t ws_size, hipStream_t stream) {
    static int grid = 0;
    if (grid == 0) {
        if (n_in != 21 || out_size != T * D || ws_size < WS_END) { fprintf(stderr, "kernel_launch: unexpected shapes (n_in %d, out %d, ws %zu < %zu)\n", n_in, out_size, ws_size, (size_t)WS_END); grid = -1; return; }
        int dev = 0, cus = 0, per_cu = 0;
        if (hipGetDevice(&dev) != hipSuccess || hipDeviceGetAttribute(&cus, hipDeviceAttributeMultiprocessorCount, dev) != hipSuccess) { grid = -1; return; }
        if (hipFuncSetAttribute((const void*)fwd, hipFuncAttributeMaxDynamicSharedMemorySize, LDS_BYTES) != hipSuccess) { fprintf(stderr, "kernel_launch: hipFuncSetAttribute failed\n"); grid = -1; return; }
        if (hipOccupancyMaxActiveBlocksPerMultiprocessor(&per_cu, (const void*)fwd, 512, LDS_BYTES) != hipSuccess || per_cu < 1) fprintf(stderr, "kernel_launch: occupancy query reports %d\n", per_cu);
        (void)hipGetLastError();
        grid = cus;
    }
    if (grid < 0) return;
    (void)hipMemsetAsync((char*)d_ws + WS_CTL, 0, CTL_BYTES, stream);
    Args a{};
    for (int i = 0; i < 21; ++i) a.in[i] = (const float*)d_in[i];
    a.out = (float*)d_out; a.ws = (unsigned char*)d_ws;
#if MK_N_LAUNCHES == 1
    a.ph_lo = 0; a.ph_hi = NPHASE;
    hipLaunchKernelGGL(fwd, dim3(grid), dim3(512), LDS_BYTES, stream, a);
#else
    for (int p = 0; p < NPHASE; ++p) { a.ph_lo = p; a.ph_hi = p + 1; hipLaunchKernelGGL(fwd, dim3(grid), dim3(512), LDS_BYTES, stream, a); }
#endif
    (void)in_sizes;
}
```
